# Optimizing an MI355X kernel written in HIP

```python
import math
import jax, jax.numpy as jnp
from jax import lax
import numpy as np

D_MODEL = 1024
BATCH = 8
SEQ = 2048
DEPTH = 1
DEC_BATCH = 2
DEC_SEQ = 16384
PAST_LEN = 128

D_CONV = 512
CONV_K = 3
N_DIFF_HEADS = 4
DIFF_HEAD_DIM = 64
D_ATTN = N_DIFF_HEADS * 2 * DIFF_HEAD_DIM
ROT_DIM = DIFF_HEAD_DIM // 4
ROPE_THETA = 500000.0
Q_BLOCK = 128
EPS = 1e-6
IN_COLS = 4 * D_CONV + 4 * D_ATTN + 2 * D_MODEL

kernel_name = "hybrid_conv_diffattn_encoder"


def rms_norm(x, g):
    xf = x.astype(jnp.float32)
    y = xf * lax.rsqrt(jnp.mean(xf * xf, axis=-1, keepdims=True) + EPS)
    return (y * g.astype(jnp.float32)).astype(x.dtype)


def rope_partial(x, pos):
    half = ROT_DIM // 2
    inv = ROPE_THETA ** (-jnp.arange(half, dtype=jnp.float32) / half)
    ang = pos.astype(jnp.float32)[:, None] * inv[None, :]
    cos, sin = jnp.cos(ang), jnp.sin(ang)
    xr = x[..., :ROT_DIM].astype(jnp.float32)
    x1, x2 = xr[..., :half], xr[..., half:]
    rot = jnp.concatenate([x1 * cos - x2 * sin, x2 * cos + x1 * sin], axis=-1).astype(x.dtype)
    return jnp.concatenate([rot, x[..., ROT_DIM:]], axis=-1)


def depthwise_conv_centred(u, w):
    pad = (CONV_K - 1) // 2
    return lax.conv_general_dilated(
        u, w[:, None, :].astype(u.dtype), window_strides=(1,), padding=[(pad, pad)],
        dimension_numbers=('NWC', 'WIO', 'NWC'), feature_group_count=u.shape[-1])


def diff_attention(q, k, v, lam):
    B, H, _, S, Dh = q.shape
    nb = S // Q_BLOCK
    scale = Dh ** -0.5
    qb = q.reshape(B, H, 2, nb, Q_BLOCK, Dh).transpose(3, 0, 1, 2, 4, 5)

    def one_block(qblk):
        s = jnp.einsum('bhcqd,bhckd->bhcqk', qblk, k,
                       preferred_element_type=jnp.float32) * scale
        p = jax.nn.softmax(s, axis=-1)
        a = p[:, :, 0] - lam * p[:, :, 1]
        o = jnp.einsum('bhqk,bhkv->bhqv', a.astype(v.dtype), v,
                       preferred_element_type=jnp.float32)
        return o.astype(v.dtype)

    out = lax.map(one_block, qb)
    return out.transpose(1, 2, 0, 3, 4).reshape(B, H, S, 2 * Dh)


def encoder_layer(x, cond, layer_idx, norm_g, w_ada, b_ada, w_in, conv_w, q_norm_g, k_norm_g,
                  lam_q1, lam_k1, lam_q2, lam_k2, subln_g, w_conv_out, w_attn_out, w_out):
    B, S, _ = x.shape
    H, Dh = N_DIFF_HEADS, DIFF_HEAD_DIM
    mod = jax.nn.silu(cond) @ w_ada + b_ada
    shift, scale, gate = jnp.split(mod[:, None, :], 3, axis=-1)
    h = rms_norm(x, norm_g) * (1 + scale) + shift

    proj = h @ w_in
    sizes = [D_CONV] * 4 + [D_ATTN] * 4 + [D_MODEL] * 2
    cuts = np.cumsum(sizes)[:-1].tolist()
    cb, cc, cx, cz, q, k, v, az, ga, gb = jnp.split(proj, cuts, axis=-1)

    y_conv = cb * depthwise_conv_centred(cc * cx, conv_w)
    y_conv = y_conv * jax.nn.silu(cz)
    branch_a = y_conv @ w_conv_out

    pos = jnp.arange(S)
    q = q.reshape(B, S, H, 2, Dh).transpose(0, 2, 3, 1, 4)
    k = k.reshape(B, S, H, 2, Dh).transpose(0, 2, 3, 1, 4)
    v = v.reshape(B, S, H, 2 * Dh).transpose(0, 2, 1, 3)
    q = rope_partial(rms_norm(q, q_norm_g), pos)
    k = rope_partial(rms_norm(k, k_norm_g), pos)
    lam_init = 0.8 - 0.6 * math.exp(-0.3 * layer_idx)
    lam = (jnp.exp(jnp.sum(lam_q1.astype(jnp.float32) * lam_k1.astype(jnp.float32)))
           - jnp.exp(jnp.sum(lam_q2.astype(jnp.float32) * lam_k2.astype(jnp.float32)))
           + lam_init)
    o = diff_attention(q, k, v, lam)
    o = rms_norm(o, subln_g) * (1.0 - lam_init)
    o = o.transpose(0, 2, 1, 3).reshape(B, S, D_ATTN) * jax.nn.silu(az)
    branch_b = o @ w_attn_out

    merged = jax.nn.sigmoid(ga) * branch_a + jax.nn.sigmoid(gb) * branch_b
    return x + gate * (merged @ w_out)


def setup_inputs(seed: int = 0) -> dict:
    key = jax.random.key(seed)
    ks = jax.random.split(key, 20)
    f32 = jnp.float32
    D = D_MODEL
    nrm = lambda k, shape: jax.random.normal(k, shape, f32)
    return {
        "x_prompt": nrm(ks[0], (BATCH, SEQ, D)),
        "x_sample": nrm(ks[1], (DEC_BATCH, DEC_SEQ, D)),
        "c_prompt": nrm(ks[2], (BATCH, D)),
        "c_sample": nrm(ks[3], (DEC_BATCH, D)),
        "norm_g": 1.0 + 0.02 * nrm(ks[4], (DEPTH, D)),
        "w_ada": 0.5 * D ** -0.5 * nrm(ks[5], (DEPTH, D, 3 * D)),
        "b_ada": 0.01 * nrm(ks[6], (DEPTH, 3 * D)),
        "w_in": D ** -0.5 * nrm(ks[7], (DEPTH, D, IN_COLS)),
        "conv_w": CONV_K ** -0.5 * nrm(ks[8], (DEPTH, CONV_K, D_CONV)),
        "q_norm_g": 1.0 + 0.02 * nrm(ks[9], (DEPTH, DIFF_HEAD_DIM)),
        "k_norm_g": 1.0 + 0.02 * nrm(ks[10], (DEPTH, DIFF_HEAD_DIM)),
        "lam_q1": 0.1 * nrm(ks[11], (DEPTH, DIFF_HEAD_DIM)),
        "lam_k1": 0.1 * nrm(ks[12], (DEPTH, DIFF_HEAD_DIM)),
        "lam_q2": 0.1 * nrm(ks[13], (DEPTH, DIFF_HEAD_DIM)),
        "lam_k2": 0.1 * nrm(ks[14], (DEPTH, DIFF_HEAD_DIM)),
        "subln_g": 1.0 + 0.02 * nrm(ks[15], (DEPTH, 2 * DIFF_HEAD_DIM)),
        "w_conv_out": D_CONV ** -0.5 * nrm(ks[16], (DEPTH, D_CONV, D)),
        "w_attn_out": D_ATTN ** -0.5 * nrm(ks[17], (DEPTH, D_ATTN, D)),
        "w_out": D ** -0.5 * nrm(ks[18], (DEPTH, D, D)),
    }


def reference(x_prompt, x_sample, c_prompt, c_sample, norm_g, w_ada, b_ada, w_in, conv_w,
              q_norm_g, k_norm_g, lam_q1, lam_k1, lam_q2, lam_k2, subln_g,
              w_conv_out, w_attn_out, w_out):
    def trunk(x, cond):
        for l in range(DEPTH):
            x = encoder_layer(x, cond, l, norm_g[l], w_ada[l], b_ada[l], w_in[l], conv_w[l],
                              q_norm_g[l], k_norm_g[l], lam_q1[l], lam_k1[l], lam_q2[l],
                              lam_k2[l], subln_g[l], w_conv_out[l], w_attn_out[l], w_out[l])
        return x

    y_prompt = trunk(x_prompt, c_prompt)
    y_sample = trunk(x_sample, c_sample)
    return (y_prompt, y_sample)
```

```cpp
#include <hip/hip_runtime.h>
#include <hip/hip_cooperative_groups.h>
#include <cmath>
#include <cstdio>
namespace cg = cooperative_groups;

#ifndef PHM
#define PHM 63
#endif
#ifndef REPM
#define REPM 0
#endif
#ifndef ONE_LAUNCH
#define ONE_LAUNCH 1
#endif

typedef unsigned short u16;
using bf16x8 = __attribute__((ext_vector_type(8))) short;
using f32x16 = __attribute__((ext_vector_type(16))) float;
using u32x4 = __attribute__((ext_vector_type(4))) unsigned;
typedef __bf16 bf2_t __attribute__((ext_vector_type(2)));
typedef float f2_t __attribute__((ext_vector_type(2)));
#define MFMA(a, b, c) __builtin_amdgcn_mfma_f32_32x32x16_bf16((a), (b), (c), 0, 0, 0)
#define DI __device__ __forceinline__
#define LAS_ __attribute__((address_space(3)))

constexpr int TP = 16384, T = 49152;
constexpr int NT = 512;
constexpr int LDS_BYTES = 139264 + 16;

constexpr size_t WS_MOD = 0;
constexpr size_t WS_WIN = 131072;
constexpr size_t WS_WC = WS_WIN + 6144ull * 1024 * 2;
constexpr size_t WS_WA = WS_WC + 1024ull * 512 * 2;
constexpr size_t WS_WO = WS_WA + 1024ull * 512 * 2;
constexpr size_t WS_H = WS_WO + 1024ull * 1024 * 2;
constexpr size_t WS_U = WS_H + (size_t)T * 1024 * 2;
constexpr size_t WS_G = WS_U + (size_t)T * 512 * 2;
constexpr size_t WS_Q = WS_G + (size_t)T * 512 * 2;
constexpr size_t WS_K = WS_Q + (size_t)T * 512 * 2;
constexpr size_t WS_V = WS_K + (size_t)T * 512 * 2;
constexpr size_t WS_AZ = WS_V + (size_t)T * 512 * 2;
constexpr size_t WS_BAR = WS_AZ + (size_t)T * 512 * 2;
constexpr size_t WS_END = WS_BAR + 16384;
constexpr size_t WS_O = WS_H;
constexpr size_t WS_MERGED = WS_Q;

struct Params {
  const float *x_p, *x_s, *c_p, *c_s, *norm_g, *w_ada, *b_ada, *w_in, *conv_w, *qg, *kg, *lq1, *lk1, *lq2, *lk2, *subln, *wc, *wa, *wo;
  float* out;
  unsigned char* ws;
  double invf[8];
  int ph_lo, ph_hi;
};

DI unsigned pack2(float a, float b) {
  f2_t v = {a, b};
  bf2_t r = __builtin_convertvector(v, bf2_t);
  return __builtin_bit_cast(unsigned, r);
}
DI float bflo(unsigned w) { return __uint_as_float(w << 16); }
DI float bfhi(unsigned w) { return __uint_as_float(w & 0xffff0000u); }
DI float sigm_f(float x) { return __builtin_amdgcn_rcpf(1.f + __builtin_amdgcn_exp2f(-1.4426950408889634f * x)); }
DI float silu_f(float x) { return x * sigm_f(x); }

DI int opaque_tid() { int t = threadIdx.x; asm volatile("" : "+v"(t)); return t; }

DI u32x4 gload16_async(const void* base, unsigned byte_off) {
  u32x4 r;
  asm volatile("global_load_dwordx4 %0, %1, %2" : "=v"(r) : "v"(byte_off), "s"(base) : "memory");
  return r;
}
DI void glds16(const void* gptr, unsigned char* ldsptr) {
  __builtin_amdgcn_global_load_lds((const unsigned*)gptr, (__attribute__((address_space(3))) unsigned*)ldsptr, 16, 0, 0);
}
DI void vm_wait0() { asm volatile("s_waitcnt vmcnt(0)" ::: "memory"); }
DI void pin(u32x4& r) { asm volatile("" : "+v"(r)); }

struct SeqInfo { int seq, s, S, tok0; };
DI SeqInfo seq_of(int t) {
  SeqInfo r;
  if (t < TP) { r.seq = t >> 11; r.s = t & 2047; r.S = 2048; r.tok0 = t & ~2047; }
  else { int u = t - TP; r.seq = 8 + (u >> 14); r.s = u & 16383; r.S = 16384; r.tok0 = TP + (u & ~16383); }
  return r;
}

template <int PT, int QT, int WP, int WQ>
DI void gemm_core(f32x16 (&acc)[PT][QT], const u16* __restrict__ Pg, int ldp, const u16* __restrict__ Qg, int ldq, int K,
                  unsigned char* lds, const u16* Pn = nullptr, const u16* Qn = nullptr, bool prologue = true) {
  constexpr int PR = WP * PT * 32, QR = WQ * QT * 32;
  constexpr int NP = PR / 64, NQ = QR / 64;
  constexpr int STAGE = (PR + QR) * 128;
  const int tid = opaque_tid(), lane = tid & 63, wave = tid >> 6;
  const int r = lane & 31, h = lane >> 5;
  const int wp = wave % WP, wq = wave / WP;
  const int lrow = tid >> 3, lc = tid & 7;
  const int gsw = lc ^ ((lrow >> 1) & 7);
  const u16* pgl = Pg + (size_t)lrow * ldp + gsw * 8;
  const u16* qgl = Qg + (size_t)lrow * ldq + gsw * 8;
  unsigned char* lw = lds + tid * 16;
  const int sw = (r >> 1) & 7;
  const int pfa = (wp * PT * 32 + r) * 128 + ((h ^ sw) << 4);
  const int qfa = PR * 128 + (wq * QT * 32 + r) * 128 + ((h ^ sw) << 4);
  const int nk = K >> 6;
  if (prologue) {
#pragma unroll
    for (int i = 0; i < NP; ++i) glds16(pgl + (size_t)i * 64 * ldp, lw + i * 8192);
#pragma unroll
    for (int i = 0; i < NQ; ++i) glds16(qgl + (size_t)i * 64 * ldq, lw + PR * 128 + i * 8192);
    vm_wait0();
    __syncthreads();
  }
  const bool chain = (Pn != nullptr);
#pragma unroll 1
  for (int kt = 0; kt < nk; ++kt) {
    const bool last = (kt + 1 == nk);
    const bool more = !last || chain;
    if (last && chain) {
      pgl = Pn + (size_t)lrow * ldp + gsw * 8 - (size_t)nk * 64;
      qgl = Qn + (size_t)lrow * ldq + gsw * 8 - (size_t)nk * 64;
    }
    const int k0 = (kt + 1) << 6;
    unsigned char* sn = lw + ((kt + 1) & 1) * STAGE;
    const unsigned char* st = lds + (kt & 1) * STAGE;
    bf16x8 pf[2][PT], qf[2][QT];
#pragma unroll
    for (int a = 0; a < PT; ++a) pf[0][a] = *(const bf16x8*)(st + a * 4096 + pfa);
#pragma unroll
    for (int b = 0; b < QT; ++b) qf[0][b] = *(const bf16x8*)(st + b * 4096 + qfa);
#pragma unroll
    for (int ks = 0; ks < 4; ++ks) {
      if (ks < 3) {
#pragma unroll
        for (int a = 0; a < PT; ++a) pf[(ks + 1) & 1][a] = *(const bf16x8*)(st + a * 4096 + (pfa ^ ((ks + 1) << 5)));
#pragma unroll
        for (int b = 0; b < QT; ++b) qf[(ks + 1) & 1][b] = *(const bf16x8*)(st + b * 4096 + (qfa ^ ((ks + 1) << 5)));
      }
      __builtin_amdgcn_sched_barrier(0);
#pragma unroll
      for (int a = 0; a < PT; ++a)
#pragma unroll
        for (int b = 0; b < QT; ++b) {
          acc[a][b] = MFMA(pf[ks & 1][a], qf[ks & 1][b], acc[a][b]);
          const int m = a * QT + b;
          if (m == 0 || m == (PT * QT) / 2) {
            const int j = 2 * ks + (m ? 1 : 0);
            if (more) {
              if (j < NP) glds16(pgl + (size_t)j * 64 * ldp + k0, sn + j * 8192);
              else if (j < NP + NQ) glds16(qgl + (size_t)(j - NP) * 64 * ldq + k0, sn + PR * 128 + (j - NP) * 8192);
            }
            __builtin_amdgcn_sched_barrier(0);
          }
        }
      __builtin_amdgcn_sched_barrier(0);
    }
    vm_wait0();
    __syncthreads();
  }
}

template <int PT, int QT, int WP, int WQ>
DI void stage_acc(const f32x16 (&acc)[PT][QT], unsigned char* img, int cs) {
  const int tid = opaque_tid(), lane = tid & 63, wave = tid >> 6;
  const int r = lane & 31, h = lane >> 5;
  const int wp = wave % WP, wq = wave / WP;
#pragma unroll
  for (int a = 0; a < PT; ++a)
#pragma unroll
    for (int b = 0; b < QT; ++b) {
      const int q = wq * QT * 32 + b * 32 + r;
      const int p0 = wp * PT * 32 + a * 32 + 4 * h;
#pragma unroll
      for (int g = 0; g < 4; ++g) {
        uint2 v;
        v.x = pack2(acc[a][b][4 * g + 0], acc[a][b][4 * g + 1]);
        v.y = pack2(acc[a][b][4 * g + 2], acc[a][b][4 * g + 3]);
        *(uint2*)(img + q * cs + (p0 + 8 * g) * 2) = v;
      }
    }
}

template <int PT, int QT>
DI void zero_acc(f32x16 (&acc)[PT][QT]) {
#pragma unroll
  for (int a = 0; a < PT; ++a)
#pragma unroll
    for (int b = 0; b < QT; ++b)
#pragma unroll
      for (int i = 0; i < 16; ++i) acc[a][b][i] = 0.f;
}


using f32x4 = __attribute__((ext_vector_type(4))) float;
DI int g8_lds_byte(int r, int c) {
  const int st = (r >> 4) * 2 + (c >> 5), rr = r & 15, cc = c & 31, ob = rr * 64 + cc * 2;
  return st * 1024 + (ob ^ (((ob >> 9) & 1) << 5));
}
DI void g8_stage_rc(int b, int& R, int& C) {
  const int st = b / 1024, sb = b % 1024, swz = sb ^ (((sb >> 9) & 1) << 5);
  R = (st >> 1) * 16 + swz / 64; C = (st & 1) * 32 + (swz % 64) / 2;
}
DI void gemm8(f32x4 (&acc)[2][2][4][2], const u16* __restrict__ A, int lda, const u16* __restrict__ Bt, int ldb, int K, unsigned char* shm) {
  const int tid = opaque_tid();
  const int wid = tid >> 6, lane = tid & 63, wr = wid >> 2, wc = wid & 3, fr = lane & 15, fq = lane >> 4;
  int r0, c0, r1, c1;
  g8_stage_rc(tid * 16, r0, c0);
  g8_stage_rc(tid * 16 + 8192, r1, c1);
  const u16* a0 = A + (size_t)r0 * lda + c0;  const u16* a1 = A + (size_t)r1 * lda + c1;
  const u16* b0 = Bt + (size_t)r0 * ldb + c0; const u16* b1 = Bt + (size_t)r1 * ldb + c1;
  const size_t ahalf = (size_t)128 * lda, bhalf = (size_t)128 * ldb;
  unsigned char* lw = shm + tid * 16;
#define G8_SA(b, h) (((b) * 2 + (h)) * 16384)
#define G8_SB(b, h) ((4 + (b) * 2 + (h)) * 16384)
#define G8_STAGE_A(b, h, kt) do { const size_t g_ = (size_t)(h) * ahalf + (size_t)(kt) * 64; \
    glds16(a0 + g_, lw + G8_SA(b, h)); glds16(a1 + g_, lw + G8_SA(b, h) + 8192); } while (0)
#define G8_STAGE_B(b, h, kt) do { const size_t g_ = (size_t)(h) * bhalf + (size_t)(kt) * 64; \
    glds16(b0 + g_, lw + G8_SB(b, h)); glds16(b1 + g_, lw + G8_SB(b, h) + 8192); } while (0)
#define G8_LDA(dst, b, h) _Pragma("unroll") for (int m = 0; m < 4; ++m) _Pragma("unroll") for (int k = 0; k < 2; ++k) \
    dst[m][k] = *(const bf16x8*)(shm + G8_SA(b, h) + g8_lds_byte(wr * 64 + m * 16 + fr, k * 32 + fq * 8))
#define G8_LDB(dst, b, h) _Pragma("unroll") for (int n = 0; n < 2; ++n) _Pragma("unroll") for (int k = 0; k < 2; ++k) \
    dst[n][k] = *(const bf16x8*)(shm + G8_SB(b, h) + g8_lds_byte(wc * 32 + n * 16 + fr, k * 32 + fq * 8))
#define G8_MMA(ai, bj, At_, Bt_) do { __builtin_amdgcn_s_setprio(1); \
    _Pragma("unroll") for (int m = 0; m < 4; ++m) _Pragma("unroll") for (int n = 0; n < 2; ++n) _Pragma("unroll") for (int k = 0; k < 2; ++k) \
      acc[ai][bj][m][n] = __builtin_amdgcn_mfma_f32_16x16x32_bf16(At_[m][k], Bt_[n][k], acc[ai][bj][m][n], 0, 0, 0); \
    __builtin_amdgcn_s_setprio(0); } while (0)
#define G8_WAIT_V(n) asm volatile("s_waitcnt vmcnt(" #n ")" ::: "memory")
#define G8_WAIT_L(n) asm volatile("s_waitcnt lgkmcnt(" #n ")" ::: "memory")
#define G8_BAR __builtin_amdgcn_s_barrier()
#define G8_SCHED __builtin_amdgcn_sched_barrier(0)
  bf16x8 At[4][2], B0[2][2], B1[2][2];
  const int nt = K / 64;
  G8_STAGE_B(0, 0, 0); G8_STAGE_A(0, 0, 0);
  G8_STAGE_B(0, 1, 0); G8_STAGE_A(0, 1, 0);
  if (wr == 1) G8_BAR;
  G8_WAIT_V(4); G8_BAR;
  G8_STAGE_B(1, 0, 1); G8_STAGE_A(1, 0, 1); G8_STAGE_B(1, 1, 1);
  G8_WAIT_V(6); G8_BAR;
#pragma unroll 1
  for (int t = 0; t < nt - 2; t += 2) {
    G8_LDB(B0, 0, 0); G8_SCHED; G8_LDA(At, 0, 0); G8_STAGE_A(1, 1, t + 1);
    G8_WAIT_L(8); G8_BAR; G8_WAIT_L(0); G8_MMA(0, 0, At, B0); G8_BAR; G8_SCHED;
    G8_LDB(B1, 0, 1); G8_STAGE_B(0, 0, t + 2);
    G8_BAR; G8_WAIT_L(0); G8_MMA(0, 1, At, B1); G8_BAR;
    G8_LDA(At, 0, 1); G8_STAGE_A(0, 0, t + 2);
    G8_BAR; G8_WAIT_L(0); G8_MMA(1, 0, At, B0); G8_BAR; G8_SCHED;
    G8_STAGE_B(0, 1, t + 2);
    G8_WAIT_V(6); G8_BAR; G8_MMA(1, 1, At, B1); G8_BAR;
    G8_LDB(B0, 1, 0); G8_SCHED; G8_LDA(At, 1, 0); G8_STAGE_A(0, 1, t + 2);
    G8_WAIT_L(8); G8_BAR; G8_WAIT_L(0); G8_MMA(0, 0, At, B0); G8_BAR; G8_SCHED;
    G8_LDB(B1, 1, 1); G8_STAGE_B(1, 0, t + 3);
    G8_BAR; G8_WAIT_L(0); G8_MMA(0, 1, At, B1); G8_BAR;
    G8_LDA(At, 1, 1); G8_STAGE_A(1, 0, t + 3);
    G8_BAR; G8_WAIT_L(0); G8_MMA(1, 0, At, B0); G8_BAR; G8_SCHED;
    G8_STAGE_B(1, 1, t + 3);
    G8_WAIT_V(6); G8_BAR; G8_MMA(1, 1, At, B1); G8_BAR;
  }
  { G8_LDB(B0, 0, 0); G8_LDA(At, 0, 0); G8_STAGE_A(1, 1, nt - 1);
    G8_BAR; G8_WAIT_L(0); G8_MMA(0, 0, At, B0); G8_BAR;
    G8_LDB(B1, 0, 1); G8_BAR; G8_WAIT_L(0); G8_MMA(0, 1, At, B1); G8_BAR;
    G8_LDA(At, 0, 1); G8_WAIT_V(4); G8_BAR; G8_WAIT_L(0); G8_MMA(1, 0, At, B0); G8_MMA(1, 1, At, B1); G8_BAR; }
  { G8_LDB(B0, 1, 0); G8_LDA(At, 1, 0); G8_WAIT_V(2); G8_BAR; G8_WAIT_L(0); G8_MMA(0, 0, At, B0); G8_BAR;
    G8_LDB(B1, 1, 1); G8_WAIT_V(0); G8_BAR; G8_WAIT_L(0); G8_MMA(0, 1, At, B1); G8_BAR;
    G8_LDA(At, 1, 1); G8_BAR; G8_WAIT_L(0); G8_MMA(1, 0, At, B0); G8_MMA(1, 1, At, B1); G8_BAR; }
  if (wr == 0) G8_BAR;
}

DI void stage_acc8(const f32x4 (&acc)[2][2][4][2], unsigned char* img, int cs) {
  const int tid = opaque_tid();
  const int wid = tid >> 6, lane = tid & 63, wr = wid >> 2, wc = wid & 3, fr = lane & 15, fq = lane >> 4;
#pragma unroll
  for (int ai = 0; ai < 2; ++ai)
#pragma unroll
    for (int bj = 0; bj < 2; ++bj)
#pragma unroll
      for (int m = 0; m < 4; ++m)
#pragma unroll
        for (int n = 0; n < 2; ++n) {
          const int q = bj * 128 + wc * 32 + n * 16 + fr;
          const int p = ai * 128 + wr * 64 + m * 16 + fq * 4;
          uint2 v;
          v.x = pack2(acc[ai][bj][m][n][0], acc[ai][bj][m][n][1]);
          v.y = pack2(acc[ai][bj][m][n][2], acc[ai][bj][m][n][3]);
          *(uint2*)(img + q * cs + p * 2) = v;
        }
}
DI void zero_acc8(f32x4 (&acc)[2][2][4][2]) {
#pragma unroll
  for (int ai = 0; ai < 2; ++ai)
#pragma unroll
    for (int bj = 0; bj < 2; ++bj)
#pragma unroll
      for (int m = 0; m < 4; ++m)
#pragma unroll
        for (int n = 0; n < 2; ++n) acc[ai][bj][m][n] = (f32x4){0.f, 0.f, 0.f, 0.f};
}

DI void phase0a(const Params& p, unsigned char* lds) {
  const int tid = threadIdx.x;
  float* modb = (float*)(p.ws + WS_MOD);
  if (blockIdx.x == 0 && tid == 0) {
    float s1 = 0.f, s2 = 0.f, mq = 0.f, mk = 0.f;
    for (int i = 0; i < 64; ++i) {
      s1 += p.lq1[i] * p.lk1[i];
      s2 += p.lq2[i] * p.lk2[i];
      mq = fmaxf(mq, fabsf(p.qg[i]));
      mk = fmaxf(mk, fabsf(p.kg[i]));
    }
    modb[30720] = __expf(s1) - __expf(s2) + 0.2f;
    modb[30721] = -(8.f * 1.4426950408889634f * mq * mk);
  }
  for (int it = blockIdx.x; it < 192; it += gridDim.x) {
    float* sc = (float*)lds;
    float* red = (float*)(lds + 40960);
    for (int i = tid; i < 10240; i += NT) {
      const int b = i >> 10, k = i & 1023;
      const float c = (b < 8) ? p.c_p[b * 1024 + k] : p.c_s[(b - 8) * 1024 + k];
      sc[i] = silu_f(c);
    }
    __syncthreads();
    const int cl = tid & 15, ks = tid >> 4;
    const int col = it * 16 + cl;
    float a[10];
#pragma unroll
    for (int b = 0; b < 10; ++b) a[b] = 0.f;
#pragma unroll 8
    for (int kk = 0; kk < 32; ++kk) {
      const int k = ks * 32 + kk;
      const float w = p.w_ada[(size_t)k * 3072 + col];
#pragma unroll
      for (int b = 0; b < 10; ++b) a[b] += sc[b * 1024 + k] * w;
    }
#pragma unroll
    for (int b = 0; b < 10; ++b) red[ks * 160 + cl * 10 + b] = a[b];
    __syncthreads();
    if (tid < 160) {
      const int c = tid / 10, b = tid % 10;
      float s = 0.f;
      for (int j = 0; j < 32; ++j) s += red[j * 160 + c * 10 + b];
      modb[b * 3072 + it * 16 + c] = s + p.b_ada[it * 16 + c];
    }
    __syncthreads();
  }
}

DI void weight_transposes(const Params& p, unsigned char* lds) {
  const int tid = threadIdx.x;
  for (int it = blockIdx.x; it < 2048; it += gridDim.x) {
    const float* src; u16* dst; int K, N, kt, nt; bool perm = false;
    if (it < 1536) { src = p.w_in; dst = (u16*)(p.ws + WS_WIN); K = 1024; N = 6144; kt = it / 96; nt = it % 96; perm = true; }
    else if (it < 1664) { int j = it - 1536; src = p.wc; dst = (u16*)(p.ws + WS_WC); K = 512; N = 1024; kt = j / 16; nt = j % 16; }
    else if (it < 1792) { int j = it - 1664; src = p.wa; dst = (u16*)(p.ws + WS_WA); K = 512; N = 1024; kt = j / 16; nt = j % 16; }
    else { int j = it - 1792; src = p.wo; dst = (u16*)(p.ws + WS_WO); K = 1024; N = 1024; kt = j / 16; nt = j % 16; }
    float* tl = (float*)lds;
    const int k0 = kt * 64, n0 = nt * 64;
#pragma unroll
    for (int i = 0; i < 8; ++i) {
      const int k = i * 8 + (tid >> 6), n = tid & 63;
      tl[k * 65 + n] = src[(size_t)(k0 + k) * N + n0 + n];
    }
    __syncthreads();
    {
      const int n = tid >> 3, kc = (tid & 7) * 8;
      float v[8];
#pragma unroll
      for (int j = 0; j < 8; ++j) v[j] = tl[(kc + j) * 65 + n];
      int nn = n0 + n;
      if (perm && nn < 2048) { const int part = nn >> 9, ch = nn & 511; nn = (ch >> 6) * 256 + part * 64 + (ch & 63); }
      uint4 o;
      o.x = pack2(v[0], v[1]); o.y = pack2(v[2], v[3]); o.z = pack2(v[4], v[5]); o.w = pack2(v[6], v[7]);
      *(uint4*)(dst + (size_t)nn * K + k0 + kc) = o;
    }
    __syncthreads();
  }
}

DI void phase0b(const Params& p, unsigned char* lds) {
  weight_transposes(p, lds);
  const int tid = threadIdx.x, lane = tid & 63, wave = tid >> 6;
  const float* modb = (const float*)(p.ws + WS_MOD);
  u16* hb = (u16*)(p.ws + WS_H);
  for (int t = blockIdx.x * 8 + wave; t < T; t += gridDim.x * 8) {
    const float* xr = (t < TP) ? p.x_p + (size_t)t * 1024 : p.x_s + (size_t)(t - TP) * 1024;
    const int seq = (t < TP) ? (t >> 11) : 8 + ((t - TP) >> 14);
    float4 v[4];
    float ss = 0.f;
#pragma unroll
    for (int i = 0; i < 4; ++i) {
      v[i] = *(const float4*)(xr + i * 256 + lane * 4);
      ss += v[i].x * v[i].x + v[i].y * v[i].y + v[i].z * v[i].z + v[i].w * v[i].w;
    }
#pragma unroll
    for (int o = 32; o > 0; o >>= 1) ss += __shfl_xor(ss, o);
    const float rstd = rsqrtf(ss * (1.f / 1024.f) + 1e-6f);
    const float* sh = modb + seq * 3072;
#pragma unroll
    for (int i = 0; i < 4; ++i) {
      const int c = i * 256 + lane * 4;
      const float4 g = *(const float4*)(p.norm_g + c);
      const float4 shf = *(const float4*)(sh + c);
      const float4 scl = *(const float4*)(sh + 1024 + c);
      const float y0 = v[i].x * rstd * g.x * (1.f + scl.x) + shf.x;
      const float y1 = v[i].y * rstd * g.y * (1.f + scl.y) + shf.y;
      const float y2 = v[i].z * rstd * g.z * (1.f + scl.z) + shf.z;
      const float y3 = v[i].w * rstd * g.w * (1.f + scl.w) + shf.w;
      uint2 o;
      o.x = pack2(y0, y1); o.y = pack2(y2, y3);
      *(uint2*)(hb + (size_t)t * 1024 + c) = o;
    }
  }
}

DI void qk_epilogue(const Params& p, const unsigned char* img, int tokm, int nt) {
  const int tid = opaque_tid();
  const bool isq = nt < 10;
  const float* gain = isq ? p.qg : p.kg;
  u16* dstb = (u16*)(p.ws + (isq ? WS_Q : WS_K));
  const float osc = isq ? (0.125f * 1.4426950408889634f) : 1.f;
  const int hb = ((nt - 8) & 1) * 2;
#pragma unroll 1
  for (int i = 0; i < 2; ++i) {
    const int id = tid + NT * i;
    const int row = id >> 2, grp = id & 3;
    const unsigned char* rp = img + row * 528 + grp * 128;
    float v[64];
    float ss = 0.f;
#pragma unroll
    for (int j = 0; j < 8; ++j) {
      const uint4 w = *(const uint4*)(rp + j * 16);
      v[8 * j + 0] = bflo(w.x); v[8 * j + 1] = bfhi(w.x); v[8 * j + 2] = bflo(w.y); v[8 * j + 3] = bfhi(w.y);
      v[8 * j + 4] = bflo(w.z); v[8 * j + 5] = bfhi(w.z); v[8 * j + 6] = bflo(w.w); v[8 * j + 7] = bfhi(w.w);
    }
#pragma unroll
    for (int d = 0; d < 64; ++d) ss += v[d] * v[d];
    const float rstd = rsqrtf(ss * (1.f / 64.f) + 1e-6f);
#pragma unroll
    for (int d = 0; d < 64; ++d) v[d] = v[d] * rstd * gain[d];
    const SeqInfo si = seq_of(tokm + row);
#pragma unroll
    for (int j = 0; j < 8; ++j) {
      double fr = (double)si.s * p.invf[j];
      fr -= rint(fr);
      const float ff = (float)fr;
      const float sn = __builtin_amdgcn_sinf(ff), cs = __builtin_amdgcn_cosf(ff);
      const float x1 = v[j], x2 = v[j + 8];
      v[j] = x1 * cs - x2 * sn;
      v[j + 8] = x2 * cs + x1 * sn;
    }
    const int head = hb + (grp >> 1), c = grp & 1;
    u16* dst = dstb + (size_t)si.tok0 * 512 + ((size_t)(head * 2 + c) * si.S + si.s) * 64;
#pragma unroll
    for (int j = 0; j < 8; ++j) {
      uint4 o;
      o.x = pack2(v[8 * j + 0] * osc, v[8 * j + 1] * osc); o.y = pack2(v[8 * j + 2] * osc, v[8 * j + 3] * osc);
      o.z = pack2(v[8 * j + 4] * osc, v[8 * j + 5] * osc); o.w = pack2(v[8 * j + 6] * osc, v[8 * j + 7] * osc);
      *(uint4*)(dst + j * 8) = o;
    }
  }
}

DI void phase1(const Params& p, unsigned char* lds) {
  const u16* hb = (const u16*)(p.ws + WS_H);
  const u16* win = (const u16*)(p.ws + WS_WIN);
  const bool xcd_map = (gridDim.x == 256);
  for (int t = blockIdx.x, it = 0; t < 192 * 24; t += gridDim.x, ++it) {
    int nt = t % 24, mt = t / 24;
    if (xcd_map) {
      const int x = blockIdx.x & 7, j = blockIdx.x >> 3;
      mt = x * 24 + (it / 3) * 4 + (j & 3);
      nt = (it % 3) * 8 + (j >> 2);
    }
    const int tokm = mt * 256;
    const u16* Hg = hb + (size_t)tokm * 1024;
    const u16* Wg = win + (size_t)nt * 256 * 1024;
    const bool vmode = (nt == 12 || nt == 13);
    f32x4 acc[2][2][4][2];
    zero_acc8(acc);
    gemm8(acc, vmode ? Hg : Wg, 1024, vmode ? Wg : Hg, 1024, 1024, lds);
    __syncthreads();
    stage_acc8(acc, lds, 528);
    __syncthreads();
    const int tid = opaque_tid();
    if (nt < 8) {
      u16* Y = (u16*)(p.ws + WS_G);
      u16* UB = (u16*)(p.ws + WS_U);
      u16* GB = (u16*)(p.ws + WS_U + (1u << 20));
      const int mt_ = tokm >> 8;
#pragma unroll 1
      for (int i = 0; i < 4; ++i) {
        const int id = tid + NT * i;
        const int row = id >> 3, j = id & 7;
        const unsigned char* rp = lds + row * 528 + j * 16;
        const uint4 vb = *(const uint4*)(rp), vc = *(const uint4*)(rp + 128), vx = *(const uint4*)(rp + 256), vz = *(const uint4*)(rp + 384);
        float u0[8], g[8];
        u0[0] = bflo(vc.x) * bflo(vx.x); u0[1] = bfhi(vc.x) * bfhi(vx.x); u0[2] = bflo(vc.y) * bflo(vx.y); u0[3] = bfhi(vc.y) * bfhi(vx.y);
        u0[4] = bflo(vc.z) * bflo(vx.z); u0[5] = bfhi(vc.z) * bfhi(vx.z); u0[6] = bflo(vc.w) * bflo(vx.w); u0[7] = bfhi(vc.w) * bfhi(vx.w);
        g[0] = bflo(vb.x) * silu_f(bflo(vz.x)); g[1] = bfhi(vb.x) * silu_f(bfhi(vz.x)); g[2] = bflo(vb.y) * silu_f(bflo(vz.y)); g[3] = bfhi(vb.y) * silu_f(bfhi(vz.y));
        g[4] = bflo(vb.z) * silu_f(bflo(vz.z)); g[5] = bfhi(vb.z) * silu_f(bfhi(vz.z)); g[6] = bflo(vb.w) * silu_f(bflo(vz.w)); g[7] = bfhi(vb.w) * silu_f(bfhi(vz.w));
        const int ch0 = nt * 64 + j * 8;
        if (row == 0 || row == 255) {
          uint4 go, uo;
          go.x = pack2(g[0], g[1]); go.y = pack2(g[2], g[3]); go.z = pack2(g[4], g[5]); go.w = pack2(g[6], g[7]);
          uo.x = pack2(u0[0], u0[1]); uo.y = pack2(u0[2], u0[3]); uo.z = pack2(u0[4], u0[5]); uo.w = pack2(u0[6], u0[7]);
          *(uint4*)(GB + ((size_t)mt_ * 2 + (row ? 1 : 0)) * 512 + ch0) = go;
          *(uint4*)(UB + ((size_t)mt_ * 4 + (row ? 3 : 0)) * 512 + ch0) = uo;
        } else {
          const uint4 pc = *(const uint4*)(rp - 528 + 128), px = *(const uint4*)(rp - 528 + 256);
          const uint4 nc = *(const uint4*)(rp + 528 + 128), nx = *(const uint4*)(rp + 528 + 256);
          float um[8], up[8];
          um[0] = bflo(pc.x) * bflo(px.x); um[1] = bfhi(pc.x) * bfhi(px.x); um[2] = bflo(pc.y) * bflo(px.y); um[3] = bfhi(pc.y) * bfhi(px.y);
          um[4] = bflo(pc.z) * bflo(px.z); um[5] = bfhi(pc.z) * bfhi(px.z); um[6] = bflo(pc.w) * bflo(px.w); um[7] = bfhi(pc.w) * bfhi(px.w);
          up[0] = bflo(nc.x) * bflo(nx.x); up[1] = bfhi(nc.x) * bfhi(nx.x); up[2] = bflo(nc.y) * bflo(nx.y); up[3] = bfhi(nc.y) * bfhi(nx.y);
          up[4] = bflo(nc.z) * bflo(nx.z); up[5] = bfhi(nc.z) * bfhi(nx.z); up[6] = bflo(nc.w) * bflo(nx.w); up[7] = bfhi(nc.w) * bfhi(nx.w);
          const float4 wa0 = *(const float4*)(p.conv_w + ch0), wa1 = *(const float4*)(p.conv_w + ch0 + 4);
          const float4 wb0 = *(const float4*)(p.conv_w + 512 + ch0), wb1 = *(const float4*)(p.conv_w + 512 + ch0 + 4);
          const float4 wc0 = *(const float4*)(p.conv_w + 1024 + ch0), wc1 = *(const float4*)(p.conv_w + 1024 + ch0 + 4);
          const float w0[8] = {wa0.x, wa0.y, wa0.z, wa0.w, wa1.x, wa1.y, wa1.z, wa1.w};
          const float w1[8] = {wb0.x, wb0.y, wb0.z, wb0.w, wb1.x, wb1.y, wb1.z, wb1.w};
          const float w2[8] = {wc0.x, wc0.y, wc0.z, wc0.w, wc1.x, wc1.y, wc1.z, wc1.w};
          float y[8];
#pragma unroll
          for (int e = 0; e < 8; ++e) y[e] = g[e] * (w0[e] * um[e] + w1[e] * u0[e] + w2[e] * up[e]);
          uint4 yo;
          yo.x = pack2(y[0], y[1]); yo.y = pack2(y[2], y[3]); yo.z = pack2(y[4], y[5]); yo.w = pack2(y[6], y[7]);
          *(uint4*)(Y + (size_t)(tokm + row) * 512 + ch0) = yo;
          if (row == 1 || row == 254) {
            uint4 uo;
            uo.x = pack2(u0[0], u0[1]); uo.y = pack2(u0[2], u0[3]); uo.z = pack2(u0[4], u0[5]); uo.w = pack2(u0[6], u0[7]);
            *(uint4*)(UB + ((size_t)mt_ * 4 + (row == 1 ? 1 : 2)) * 512 + ch0) = uo;
          }
        }
      }
    } else if (nt < 12) {
      qk_epilogue(p, lds, tokm, nt);
    } else if (nt < 14) {
      u16* VT = (u16*)(p.ws + WS_V);
      const SeqInfo si = seq_of(tokm);
#pragma unroll
      for (int i = 0; i < 16; ++i) {
        const int id = tid + NT * i;
        const int row = id >> 5, ch = id & 31;
        const uint4 v = *(const uint4*)(lds + row * 528 + ch * 16);
        const int hd = (nt - 12) * 256 + row;
        *(uint4*)(VT + (size_t)si.tok0 * 512 + (size_t)hd * si.S + si.s + ch * 8) = v;
      }
    } else {
      u16* dstb; int ld, c0;
      if (nt < 16) { dstb = (u16*)(p.ws + WS_AZ); ld = 512; c0 = (nt - 14) * 256; }
      else { dstb = (u16*)p.out; ld = 2048; c0 = (nt - 16) * 256; }
#pragma unroll
      for (int i = 0; i < 16; ++i) {
        const int id = tid + NT * i;
        const int row = id >> 5, ch = id & 31;
        const uint4 v = *(const uint4*)(lds + row * 528 + ch * 16);
        *(uint4*)(dstb + (size_t)(tokm + row) * ld + c0 + ch * 8) = v;
      }
    }
    asm volatile("s_waitcnt lgkmcnt(0)" ::: "memory");
    __builtin_amdgcn_s_barrier();
  }
}

DI void conv_pass(const Params& p) {
  const u16* UB = (const u16*)(p.ws + WS_U);
  const u16* GB = (const u16*)(p.ws + WS_U + (1u << 20));
  u16* Y = (u16*)(p.ws + WS_G);
  const int total = 192 * 2 * 64;
  for (int id = blockIdx.x * NT + threadIdx.x; id < total; id += gridDim.x * NT) {
    const int c8 = (id & 63) * 8, hi = (id >> 6) & 1, k = id >> 7;
    const int t = k * 256 + (hi ? 255 : 0);
    const SeqInfo si = seq_of(t);
    int rm = hi ? (k * 4 + 2) : ((k - 1) * 4 + 3);
    int rq = hi ? ((k + 1) * 4 + 0) : (k * 4 + 1);
    const bool vm_ = hi || (si.s > 0), vp_ = !hi || (si.s < si.S - 1);
    if (!vm_) rm = k * 4;
    if (!vp_) rq = k * 4 + 3;
    const float fm = vm_ ? 1.f : 0.f, fp = vp_ ? 1.f : 0.f;
    const uint4 um = *(const uint4*)(UB + (size_t)rm * 512 + c8);
    const uint4 u0 = *(const uint4*)(UB + ((size_t)k * 4 + (hi ? 3 : 0)) * 512 + c8);
    const uint4 up = *(const uint4*)(UB + (size_t)rq * 512 + c8);
    const uint4 g = *(const uint4*)(GB + ((size_t)k * 2 + hi) * 512 + c8);
    float4 wa0 = *(const float4*)(p.conv_w + c8), wa1 = *(const float4*)(p.conv_w + c8 + 4);
    const float4 wb0 = *(const float4*)(p.conv_w + 512 + c8), wb1 = *(const float4*)(p.conv_w + 512 + c8 + 4);
    float4 wc0 = *(const float4*)(p.conv_w + 1024 + c8), wc1 = *(const float4*)(p.conv_w + 1024 + c8 + 4);
    wa0.x *= fm; wa0.y *= fm; wa0.z *= fm; wa0.w *= fm; wa1.x *= fm; wa1.y *= fm; wa1.z *= fm; wa1.w *= fm;
    wc0.x *= fp; wc0.y *= fp; wc0.z *= fp; wc0.w *= fp; wc1.x *= fp; wc1.y *= fp; wc1.z *= fp; wc1.w *= fp;
    uint4 y;
    y.x = pack2(bflo(g.x) * (wa0.x * bflo(um.x) + wb0.x * bflo(u0.x) + wc0.x * bflo(up.x)),
                bfhi(g.x) * (wa0.y * bfhi(um.x) + wb0.y * bfhi(u0.x) + wc0.y * bfhi(up.x)));
    y.y = pack2(bflo(g.y) * (wa0.z * bflo(um.y) + wb0.z * bflo(u0.y) + wc0.z * bflo(up.y)),
                bfhi(g.y) * (wa0.w * bfhi(um.y) + wb0.w * bfhi(u0.y) + wc0.w * bfhi(up.y)));
    y.z = pack2(bflo(g.z) * (wa1.x * bflo(um.z) + wb1.x * bflo(u0.z) + wc1.x * bflo(up.z)),
                bfhi(g.z) * (wa1.y * bfhi(um.z) + wb1.y * bfhi(u0.z) + wc1.y * bfhi(up.z)));
    y.w = pack2(bflo(g.w) * (wa1.z * bflo(um.w) + wb1.z * bflo(u0.w) + wc1.z * bflo(up.w)),
                bfhi(g.w) * (wa1.w * bfhi(um.w) + wb1.w * bfhi(u0.w) + wc1.w * bfhi(up.w)));
    *(uint4*)(Y + (size_t)t * 512 + c8) = y;
  }
}

DI void attn_item(const Params& p, int item, unsigned char* lds, float lam) {
  const int tid = opaque_tid(), lane = tid & 63, wave = __builtin_amdgcn_readfirstlane(tid >> 6);
  const int r = lane & 31, h = lane >> 5;
  int tok0, S, head, qb;
  if (item < 512) {
    const int combo = item & 7; qb = item >> 3;
    tok0 = TP + (combo >> 2) * 16384; head = combo & 3; S = 16384;
  } else {
    const int j = item - 512; const int x = j & 7, jj = j >> 3;
    const int combo = x * 4 + (jj & 3); qb = jj >> 2;
    tok0 = (combo >> 2) * 2048; head = combo & 3; S = 2048;
  }
  const u16* Qb = (const u16*)(p.ws + WS_Q) + (size_t)tok0 * 512;
  const u16* Kb = (const u16*)(p.ws + WS_K) + (size_t)tok0 * 512;
  const u16* Vb = (const u16*)(p.ws + WS_V) + (size_t)tok0 * 512 + (size_t)head * 128 * S;
  const u16* K1g = Kb + (size_t)(head * 2 + 0) * S * 64;
  const u16* K2g = Kb + (size_t)(head * 2 + 1) * S * 64;
  const int qrow = qb * 256 + wave * 32 + r;
  unsigned char* qlds = lds + 65536 + wave * 8192;
  {
    const u16* qg0 = Qb + ((size_t)(head * 2) * S + qb * 256 + wave * 32) * 64;
#pragma unroll
    for (int i = 0; i < 8; ++i) {
      const int id = lane + 64 * i;
      const int c = id >> 8, row = (id >> 3) & 31, ch = id & 7;
      const uint4 v = *(const uint4*)(qg0 + ((size_t)c * S + row) * 64 + ch * 8);
      *(uint4*)(qlds + c * 4096 + row * 128 + ((ch ^ ((row >> 1) & 7)) << 4)) = v;
    }
  }
  f32x16 O1[4], O2[4];
#pragma unroll
  for (int a = 0; a < 4; ++a)
#pragma unroll
    for (int i = 0; i < 16; ++i) { O1[a][i] = 0.f; O2[a][i] = 0.f; }
  float l1 = 0.f, l2 = 0.f;

  const int lrow = tid >> 3, lc = tid & 7;
  const int gsw = lc ^ ((lrow >> 1) & 7);
  const __amdgpu_buffer_rsrc_t srdK1 = __builtin_amdgcn_make_buffer_rsrc((void*)K1g, (short)0, S * 128, 0x00020000);
  const __amdgpu_buffer_rsrc_t srdK2 = __builtin_amdgcn_make_buffer_rsrc((void*)K2g, (short)0, S * 128, 0x00020000);
  const __amdgpu_buffer_rsrc_t srdV = __builtin_amdgcn_make_buffer_rsrc((void*)Vb, (short)0, S * 256, 0x00020000);
  const unsigned kvo = (lrow * 64 + gsw * 8) * 2;
  const unsigned vvo = (lrow * S + gsw * 8) * 2;
  const unsigned m0w = (unsigned)(size_t)((LAS_ unsigned char*)lds) + wave * 1024;
#define AT_DMA(m0v, voff, srd, soff) asm volatile("s_mov_b32 m0, %0\n\ts_nop 0\n\tbuffer_load_dwordx4 %1, %2, %3 offen lds" \
      :: "s"((unsigned)(m0v)), "v"(voff), "s"(srd), "s"((unsigned)(soff)) : "m0", "memory")
  const int kr = (r & 19) | ((r & 4) << 1) | ((r & 8) >> 1);
  const int ksw = (kr >> 1) & 7;
  const int vsw = (r >> 1) & 7;
  const int ka0 = kr * 128 + ((h ^ ksw) << 4);
  const int qa0 = r * 128 + ((h ^ vsw) << 4);
  const int va0 = 16384 + r * 128 + ((h ^ vsw) << 4);

  AT_DMA(m0w, kvo, srdK1, 0u); AT_DMA(m0w + 8192u, kvo, srdK2, 0u);
  AT_DMA(m0w + 16384u, vvo, srdV, 0u); AT_DMA(m0w + 24576u, vvo, srdV, (unsigned)S * 128u);
  vm_wait0();
  __syncthreads();
  const int nkt = S >> 6;
#pragma unroll 1
  for (int kt = 0; kt < nkt; ++kt) {
    if (kt + 1 < nkt) {
      const unsigned key0 = (unsigned)(kt + 1) << 6;
      const unsigned mn = m0w + (unsigned)((kt + 1) & 1) * 32768u;
      AT_DMA(mn, kvo, srdK1, key0 * 128u); AT_DMA(mn + 8192u, kvo, srdK2, key0 * 128u);
      AT_DMA(mn + 16384u, vvo, srdV, key0 * 2u); AT_DMA(mn + 24576u, vvo, srdV, key0 * 2u + (unsigned)S * 128u);
    }
    const unsigned char* st = lds + (kt & 1) * 32768;
#pragma unroll
    for (int kb = 0; kb < 2; ++kb) {
      f32x16 s1, s2;
#pragma unroll
      for (int i = 0; i < 16; ++i) { s1[i] = 0.f; s2[i] = 0.f; }
#pragma unroll
      for (int ks = 0; ks < 4; ++ks) {
        const bf16x8 a1 = *(const bf16x8*)(st + kb * 4096 + (ka0 ^ (ks << 5)));
        const bf16x8 b1 = *(const bf16x8*)(qlds + (qa0 ^ (ks << 5)));
        s1 = MFMA(a1, b1, s1);
        const bf16x8 a2 = *(const bf16x8*)(st + 8192 + kb * 4096 + (ka0 ^ (ks << 5)));
        const bf16x8 b2 = *(const bf16x8*)(qlds + 4096 + (qa0 ^ (ks << 5)));
        s2 = MFMA(a2, b2, s2);
      }
      unsigned pb1[8], pb2[8];
#pragma unroll
      for (int i = 0; i < 8; ++i) {
        const float e0 = __builtin_amdgcn_exp2f(s1[2 * i]), e1 = __builtin_amdgcn_exp2f(s1[2 * i + 1]);
        l1 += e0 + e1;
        pb1[i] = pack2(e0, e1);
        const float f0 = __builtin_amdgcn_exp2f(s2[2 * i]), f1 = __builtin_amdgcn_exp2f(s2[2 * i + 1]);
        l2 += f0 + f1;
        pb2[i] = pack2(f0, f1);
      }
#pragma unroll
      for (int s = 0; s < 2; ++s) {
        bf16x8 b1, b2;
        {
          uint4 t1 = {pb1[4 * s], pb1[4 * s + 1], pb1[4 * s + 2], pb1[4 * s + 3]};
          uint4 t2 = {pb2[4 * s], pb2[4 * s + 1], pb2[4 * s + 2], pb2[4 * s + 3]};
          b1 = __builtin_bit_cast(bf16x8, t1);
          b2 = __builtin_bit_cast(bf16x8, t2);
        }
        const int vo = va0 ^ ((kb * 4 + 2 * s) << 4);
#pragma unroll
        for (int dvt = 0; dvt < 4; ++dvt) {
          const bf16x8 vf = *(const bf16x8*)(st + dvt * 4096 + vo);
          O1[dvt] = MFMA(vf, b1, O1[dvt]);
          O2[dvt] = MFMA(vf, b2, O2[dvt]);
        }
      }
    }
    vm_wait0();
    __syncthreads();
  }
#undef AT_DMA
  const int tidf = opaque_tid();
  const int hf = (tidf >> 5) & 1;
  const int qrowf = qb * 256 + (tidf >> 6) * 32 + (tidf & 31);
  l1 += __shfl_xor(l1, 32);
  l2 += __shfl_xor(l2, 32);
  const float i1 = 1.f / l1, i2 = lam / l2;
  float ss = 0.f;
#pragma unroll
  for (int a = 0; a < 4; ++a)
#pragma unroll
    for (int i = 0; i < 16; ++i) {
      const float o = O1[a][i] * i1 - O2[a][i] * i2;
      O1[a][i] = o;
      ss += o * o;
    }
  ss += __shfl_xor(ss, 32);
  const float rstd = rsqrtf(ss * (1.f / 128.f) + 1e-6f) * 0.8f;
  const size_t tok = (size_t)tok0 + qrowf;
  const u16* azr = (const u16*)(p.ws + WS_AZ) + tok * 512 + head * 128;
  u16* orow = (u16*)(p.ws + WS_O) + tok * 512 + head * 128;
#pragma unroll
  for (int a = 0; a < 4; ++a)
#pragma unroll
    for (int g = 0; g < 4; ++g) {
      __builtin_amdgcn_sched_barrier(0);
      const int dv0 = a * 32 + 8 * g + 4 * hf;
      const uint2 az = *(const uint2*)(azr + dv0);
      const float4 sg = *(const float4*)(p.subln + dv0);
      const float y0 = O1[a][4 * g + 0] * rstd * sg.x * silu_f(bflo(az.x));
      const float y1 = O1[a][4 * g + 1] * rstd * sg.y * silu_f(bfhi(az.x));
      const float y2 = O1[a][4 * g + 2] * rstd * sg.z * silu_f(bflo(az.y));
      const float y3 = O1[a][4 * g + 3] * rstd * sg.w * silu_f(bfhi(az.y));
      uint2 o;
      o.x = pack2(y0, y1); o.y = pack2(y2, y3);
      *(uint2*)(orow + dv0) = o;
    }
}

DI void phase2(const Params& p, unsigned char* lds) {
  conv_pass(p);
  const float* modb = (const float*)(p.ws + WS_MOD);
  const float lam = modb[30720];
  for (int rep = 0; rep < 1 + ((REPM >> 3) & 1); ++rep)
    for (int item = blockIdx.x; item < 768; item += gridDim.x) attn_item(p, item, lds, lam);
}

DI void load_acc8(f32x4 (&acc)[2][2][4][2], const unsigned char* img, int cs) {
  const int tid = opaque_tid();
  const int wid = tid >> 6, lane = tid & 63, wr = wid >> 2, wc = wid & 3, fr = lane & 15, fq = lane >> 4;
#pragma unroll
  for (int ai = 0; ai < 2; ++ai)
#pragma unroll
    for (int bj = 0; bj < 2; ++bj)
#pragma unroll
      for (int m = 0; m < 4; ++m)
#pragma unroll
        for (int n = 0; n < 2; ++n) {
          const int q = bj * 128 + wc * 32 + n * 16 + fr;
          const int pp = ai * 128 + wr * 64 + m * 16 + fq * 4;
          const uint2 v = *(const uint2*)(img + q * cs + pp * 2);
          acc[ai][bj][m][n] = (f32x4){bflo(v.x), bfhi(v.x), bflo(v.y), bfhi(v.y)};
        }
}

DI void phase3a(const Params& p, unsigned char* lds) {
  const u16* Y = (const u16*)(p.ws + WS_G);
  const u16* O = (const u16*)(p.ws + WS_O);
  const u16* WC = (const u16*)(p.ws + WS_WC);
  const u16* WA = (const u16*)(p.ws + WS_WA);
  const u16* GAB = (const u16*)p.out;
  u16* MG = (u16*)(p.ws + WS_MERGED);
  const bool xcd_map = (gridDim.x == 256);
  for (int t = blockIdx.x, it = 0; t < 192 * 4; t += gridDim.x, ++it) {
    int nt = t & 3, mt = t >> 2;
    if (xcd_map) {
      const int x = blockIdx.x & 7, j = blockIdx.x >> 3;
      mt = x * 24 + it * 8 + (j & 7);
      nt = j >> 3;
    }
    const int tokm = mt * 256;
    f32x4 acc[2][2][4][2];
    zero_acc8(acc);
    gemm8(acc, WC + (size_t)nt * 256 * 512, 512, Y + (size_t)tokm * 512, 512, 512, lds);
    __syncthreads();
    stage_acc8(acc, lds, 528);
    __syncthreads();
    {
      const int tid = opaque_tid();
#pragma unroll 4
      for (int i = 0; i < 16; ++i) {
        const int id = tid + NT * i;
        const int row = id >> 5, ch = id & 31;
        unsigned char* ip = lds + row * 528 + ch * 16;
        const uint4 a = *(const uint4*)ip;
        const size_t go = (size_t)(tokm + row) * 2048 + nt * 256 + ch * 8;
        const uint4 ga = *(const uint4*)(GAB + go);
        const uint4 gb = *(const uint4*)(GAB + go + 1024);
#define P3A_R(gaw, gbw, lohi) ((1.f + __builtin_amdgcn_exp2f(-1.4426950408889634f * lohi(gbw))) * __builtin_amdgcn_rcpf(1.f + __builtin_amdgcn_exp2f(-1.4426950408889634f * lohi(gaw))))
        uint4 o;
        o.x = pack2(bflo(a.x) * P3A_R(ga.x, gb.x, bflo), bfhi(a.x) * P3A_R(ga.x, gb.x, bfhi));
        o.y = pack2(bflo(a.y) * P3A_R(ga.y, gb.y, bflo), bfhi(a.y) * P3A_R(ga.y, gb.y, bfhi));
        o.z = pack2(bflo(a.z) * P3A_R(ga.z, gb.z, bflo), bfhi(a.z) * P3A_R(ga.z, gb.z, bfhi));
        o.w = pack2(bflo(a.w) * P3A_R(ga.w, gb.w, bflo), bfhi(a.w) * P3A_R(ga.w, gb.w, bfhi));
#undef P3A_R
        *(uint4*)ip = o;
      }
    }
    __syncthreads();
    load_acc8(acc, lds, 528);
    __syncthreads();
    gemm8(acc, WA + (size_t)nt * 256 * 512, 512, O + (size_t)tokm * 512, 512, 512, lds);
    __syncthreads();
    stage_acc8(acc, lds, 528);
    __syncthreads();
    {
      const int tid = opaque_tid();
#pragma unroll 4
      for (int i = 0; i < 16; ++i) {
        const int id = tid + NT * i;
        const int row = id >> 5, ch = id & 31;
        const uint4 a = *(const uint4*)(lds + row * 528 + ch * 16);
        const size_t go = (size_t)(tokm + row) * 2048 + nt * 256 + ch * 8;
        const uint4 gb = *(const uint4*)(GAB + go + 1024);
        uint4 m;
        m.x = pack2(sigm_f(bflo(gb.x)) * bflo(a.x), sigm_f(bfhi(gb.x)) * bfhi(a.x));
        m.y = pack2(sigm_f(bflo(gb.y)) * bflo(a.y), sigm_f(bfhi(gb.y)) * bfhi(a.y));
        m.z = pack2(sigm_f(bflo(gb.z)) * bflo(a.z), sigm_f(bfhi(gb.z)) * bfhi(a.z));
        m.w = pack2(sigm_f(bflo(gb.w)) * bflo(a.w), sigm_f(bfhi(gb.w)) * bfhi(a.w));
        *(uint4*)(MG + (size_t)(tokm + row) * 1024 + nt * 256 + ch * 8) = m;
      }
    }
    asm volatile("s_waitcnt lgkmcnt(0)" ::: "memory");
    __builtin_amdgcn_s_barrier();
  }
}

DI void phase3b(const Params& p, unsigned char* lds) {
  const u16* MG = (const u16*)(p.ws + WS_MERGED);
  const u16* WO = (const u16*)(p.ws + WS_WO);
  const float* modb = (const float*)(p.ws + WS_MOD);
  for (int t = blockIdx.x; t < 192 * 4; t += gridDim.x) {
    const int nt = t & 3, mt = t >> 2;
    const int tokm = mt * 256;
    f32x4 acc[2][2][4][2];
    zero_acc8(acc);
    gemm8(acc, WO + (size_t)nt * 256 * 1024, 1024, MG + (size_t)tokm * 1024, 1024, 1024, lds);
    __syncthreads();
    stage_acc8(acc, lds, 528);
    __syncthreads();
    const int tid = opaque_tid();
    const int seq = (tokm < TP) ? (tokm >> 11) : 8 + ((tokm - TP) >> 14);
    const float* gate = modb + seq * 3072 + 2048 + nt * 256;
#pragma unroll
    for (int i = 0; i < 16; ++i) {
      const int id = tid + NT * i;
      const int row = id >> 5, ch = id & 31;
      const uint4 a = *(const uint4*)(lds + row * 528 + ch * 16);
      const int tk = tokm + row;
      const float* xr = ((tk < TP) ? p.x_p + (size_t)tk * 1024 : p.x_s + (size_t)(tk - TP) * 1024) + nt * 256 + ch * 8;
      float* orow = p.out + (size_t)tk * 1024 + nt * 256 + ch * 8;
      const float4 x0 = *(const float4*)(xr), x1 = *(const float4*)(xr + 4);
      const float4 g0 = *(const float4*)(gate + ch * 8), g1 = *(const float4*)(gate + ch * 8 + 4);
      float4 o0, o1;
      o0.x = x0.x + g0.x * bflo(a.x); o0.y = x0.y + g0.y * bfhi(a.x); o0.z = x0.z + g0.z * bflo(a.y); o0.w = x0.w + g0.w * bfhi(a.y);
      o1.x = x1.x + g1.x * bflo(a.z); o1.y = x1.y + g1.y * bfhi(a.z); o1.z = x1.z + g1.z * bflo(a.w); o1.w = x1.w + g1.w * bfhi(a.w);
      *(float4*)(orow) = o0;
      *(float4*)(orow + 4) = o1;
    }
    asm volatile("s_waitcnt lgkmcnt(0)" ::: "memory");
    __builtin_amdgcn_s_barrier();
  }
}


#define XB_TMO      128
#define XB_XCNT(j)  (256  + 64 * (j))
#define XB_XSUB(j)  (1280 + 64 * (j))
#define XB_XGEN(j)  (2304 + 64 * (j))
#define XB_TOP      3328
#define XB_TOPGEN   3392
#define XCD_BAR_WORDS 3456
#define XB_SPIN_CAP (1u << 18)
#define LAS __attribute__((address_space(3)))
DI unsigned xb_ld(unsigned* p) { return __hip_atomic_load(p, __ATOMIC_RELAXED, __HIP_MEMORY_SCOPE_AGENT); }
DI unsigned xb_add(unsigned* p, unsigned v) { return __hip_atomic_fetch_add(p, v, __ATOMIC_RELAXED, __HIP_MEMORY_SCOPE_AGENT); }
DI unsigned xb_xcc_id() { return (unsigned)__builtin_amdgcn_s_getreg((3 << 11) | 20) & 0xFu; }
#define XB_SPIN(cond, bar) do { unsigned _sp = 0; while (cond) { __builtin_amdgcn_s_sleep(1); \
    if ((++_sp & 255u) == 0u) { if (xb_ld(&(bar)[XB_TMO])) break; if (_sp > XB_SPIN_CAP) { atomicAdd(&(bar)[XB_TMO], 1u); break; } } } } while (0)
struct XcdBarrier { unsigned* bar; unsigned x; volatile LAS unsigned* st; };
DI XcdBarrier xcd_barrier_post(unsigned* bar, volatile LAS unsigned* st) {
  XcdBarrier b; b.bar = bar; b.x = xb_xcc_id(); b.st = st;
  if (threadIdx.x == 0) (void)xb_add(&bar[XB_XCNT(b.x)], 1u);
  return b;
}
DI void xcd_barrier_complete(unsigned* bar, unsigned x, unsigned& nloc, unsigned& nx) {
  const unsigned G = gridDim.x * gridDim.y * gridDim.z;
  unsigned sum, cnt, mine, sp = 0u;
  for (;;) {
    sum = 0u; cnt = 0u; mine = 0u;
#pragma unroll
    for (unsigned j = 0; j < 16; ++j) { const unsigned c = xb_ld(&bar[XB_XCNT(j)]); sum += c; cnt += (c > 0u) ? 1u : 0u; mine = (j == x) ? c : mine; }
    if (sum == G) break;
    __builtin_amdgcn_s_sleep(1);
    if ((++sp & 255u) == 0u) { if (xb_ld(&bar[XB_TMO])) break; if (sp > XB_SPIN_CAP) { atomicAdd(&bar[XB_TMO], 1u); break; } }
  }
  nloc = mine > 0u ? mine : 1u; nx = cnt > 0u ? cnt : 1u;
}
DI void xcd_barrier(const XcdBarrier& b) {
  asm volatile("s_waitcnt vmcnt(0)" ::: "memory");
  __syncthreads();
  if (threadIdx.x == 0) {
    unsigned* bar = b.bar;
    __builtin_amdgcn_s_waitcnt(0);
    unsigned nloc = b.st[0], nx = b.st[1];
    if (nloc == 0u) { xcd_barrier_complete(bar, b.x, nloc, nx); b.st[0] = nloc; b.st[1] = nx; }
    const unsigned old = xb_add(&bar[XB_XSUB(b.x)], 1u);
    const unsigned gen = old / nloc;
    if (old + 1u == (gen + 1u) * nloc) {
      __builtin_amdgcn_fence(__ATOMIC_RELEASE, "agent");
      asm volatile("s_waitcnt vmcnt(0)" ::: "memory");
      const unsigned og = xb_add(&bar[XB_TOP], 1u);
      const unsigned tg = og / nx;
      if (og + 1u == (tg + 1u) * nx) xb_add(&bar[XB_TOPGEN], 1u);
      else XB_SPIN(xb_ld(&bar[XB_TOPGEN]) == tg, bar);
      __builtin_amdgcn_fence(__ATOMIC_ACQUIRE, "agent");
      xb_add(&bar[XB_XGEN(b.x)], 1u);
      asm volatile("s_waitcnt vmcnt(0)" ::: "memory");
    } else {
      XB_SPIN(xb_ld(&bar[XB_XGEN(b.x)]) == gen, bar);
      __builtin_amdgcn_fence(__ATOMIC_ACQUIRE, "agent");
      asm volatile("s_waitcnt vmcnt(0)" ::: "memory");
    }
  }
  __syncthreads();
}

__global__ void __launch_bounds__(512) fwd_kernel(Params p) {
  extern __shared__ __attribute__((aligned(16))) unsigned char lds[];
  cg::grid_group grid = cg::this_grid();
  const int lo = p.ph_lo, hi = p.ph_hi;
  unsigned* barw = (unsigned*)(p.ws + WS_BAR);
  volatile LAS unsigned* st = (volatile LAS unsigned*)(lds + 139264);
  XcdBarrier xb; xb.bar = barw; xb.x = 0; xb.st = st;
  if ((PHM & 1) && lo <= 0 && 0 < hi) {
    if (1 < hi && blockIdx.x == 0) for (int i = threadIdx.x; i < XCD_BAR_WORDS; i += NT) barw[i] = 0u;
    for (int rep = 0; rep < 1 + ((REPM >> 0) & 1); ++rep) phase0a(p, lds);
    if (1 < hi) {
      grid.sync();
      if (threadIdx.x < 4) st[threadIdx.x] = 0u;
      __syncthreads();
      xb = xcd_barrier_post(barw, st);
    }
  }
  if ((PHM & 2) && lo <= 1 && 1 < hi) { for (int rep = 0; rep < 1 + ((REPM >> 1) & 1); ++rep) phase0b(p, lds); if (2 < hi) xcd_barrier(xb); }
  if ((PHM & 4) && lo <= 2 && 2 < hi) { for (int rep = 0; rep < 1 + ((REPM >> 2) & 1); ++rep) phase1(p, lds); if (3 < hi) xcd_barrier(xb); }
  if ((PHM & 8) && lo <= 3 && 3 < hi) { phase2(p, lds); if (4 < hi) xcd_barrier(xb); }
  if ((PHM & 16) && lo <= 4 && 4 < hi) { for (int rep = 0; rep < 1 + ((REPM >> 4) & 1); ++rep) phase3a(p, lds); if (5 < hi) xcd_barrier(xb); }
  if ((PHM & 32) && lo <= 5 && 5 < hi) { for (int rep = 0; rep < 1 + ((REPM >> 5) & 1); ++rep) phase3b(p, lds); }
}

extern "C" void kernel_launch(void* const* d_in, const int* in_sizes, int n_in, void* d_out, int out_size, void* d_ws, size_t ws_size,
                              hipStream_t stream) {
  static int grid = 0;
  if (grid == 0) {
    int dev = 0, cus = 0, per_cu = 0;
    hipGetDevice(&dev);
    hipDeviceGetAttribute(&cus, hipDeviceAttributeMultiprocessorCount, dev);
    hipFuncSetAttribute((const void*)fwd_kernel, hipFuncAttributeMaxDynamicSharedMemorySize, LDS_BYTES);
    hipOccupancyMaxActiveBlocksPerMultiprocessor(&per_cu, (const void*)fwd_kernel, NT, LDS_BYTES);
    if (per_cu < 1) { fprintf(stderr, "occupancy query returned %d\n", per_cu); per_cu = 1; }
    if (per_cu > 1) per_cu = 1;
    grid = cus * per_cu;
    if (ws_size < WS_END) fprintf(stderr, "workspace too small: %zu < %zu\n", ws_size, (size_t)WS_END);
  }
  Params p{};
  const float** f = (const float**)&p;
  for (int i = 0; i < 19; ++i) f[i] = (const float*)d_in[i];
  p.out = (float*)d_out;
  p.ws = (unsigned char*)d_ws;
  for (int i = 0; i < 8; ++i) p.invf[i] = pow(500000.0, -(double)i / 8.0) / (2.0 * M_PI);
#if ONE_LAUNCH
  p.ph_lo = 0; p.ph_hi = 6;
  void* args[] = {&p};
  hipError_t e = hipLaunchCooperativeKernel((const void*)fwd_kernel, dim3(grid), dim3(NT), args, LDS_BYTES, stream);
  if (e != hipSuccess) fprintf(stderr, "cooperative launch failed: %s (grid %d)\n", hipGetErrorString(e), grid);
#else
  for (int ph = 0; ph < 6; ++ph) {
    p.ph_lo = ph; p.ph_hi = ph + 1;
    hipLaunchKernelGGL(fwd_kernel, dim3(grid), dim3(NT), LDS_BYTES, stream, p);
  }
#endif
}
```

```cpp
#include <hip/hip_runtime.h>
#include <hip/hip_cooperative_groups.h>
#include <cmath>
#include <cstdio>
namespace cg = cooperative_groups;

#ifndef PHM
#define PHM 63
#endif
#ifndef REPM
#define REPM 0
#endif
#ifndef ONE_LAUNCH
#define ONE_LAUNCH 1
#endif

typedef unsigned short u16;
using bf16x8 = __attribute__((ext_vector_type(8))) short;
using f32x16 = __attribute__((ext_vector_type(16))) float;
using u32x4 = __attribute__((ext_vector_type(4))) unsigned;
typedef __bf16 bf2_t __attribute__((ext_vector_type(2)));
typedef float f2_t __attribute__((ext_vector_type(2)));
#define MFMA(a, b, c) __builtin_amdgcn_mfma_f32_32x32x16_bf16((a), (b), (c), 0, 0, 0)
#define DI __device__ __forceinline__
#define LAS_ __attribute__((address_space(3)))

constexpr int TP = 16384, T = 49152;
constexpr int NT = 512;
constexpr int LDS_BYTES = 139264 + 16;

constexpr size_t WS_MOD = 0;
constexpr size_t WS_WIN = 131072;
constexpr size_t WS_WC = WS_WIN + 6144ull * 1024 * 2;
constexpr size_t WS_WA = WS_WC + 1024ull * 512 * 2;
constexpr size_t WS_WO = WS_WA + 1024ull * 512 * 2;
constexpr size_t WS_H = WS_WO + 1024ull * 1024 * 2;
constexpr size_t WS_U = WS_H + (size_t)T * 1024 * 2;
constexpr size_t WS_G = WS_U + (size_t)T * 512 * 2;
constexpr size_t WS_Q = WS_G + (size_t)T * 512 * 2;
constexpr size_t WS_K = WS_Q + (size_t)T * 512 * 2;
constexpr size_t WS_V = WS_K + (size_t)T * 512 * 2;
constexpr size_t WS_AZ = WS_V + (size_t)T * 512 * 2;
constexpr size_t WS_BAR = WS_AZ + (size_t)T * 512 * 2;
constexpr size_t WS_END = WS_BAR + 16384;
constexpr size_t WS_O = WS_H;
constexpr size_t WS_MERGED = WS_Q;

struct Params {
  const float *x_p, *x_s, *c_p, *c_s, *norm_g, *w_ada, *b_ada, *w_in, *conv_w, *qg, *kg, *lq1, *lk1, *lq2, *lk2, *subln, *wc, *wa, *wo;
  float* out;
  unsigned char* ws;
  double invf[8];
  int ph_lo, ph_hi;
};

DI unsigned pack2(float a, float b) {
  f2_t v = {a, b};
  bf2_t r = __builtin_convertvector(v, bf2_t);
  return __builtin_bit_cast(unsigned, r);
}
DI float bflo(unsigned w) { return __uint_as_float(w << 16); }
DI float bfhi(unsigned w) { return __uint_as_float(w & 0xffff0000u); }
DI float sigm_f(float x) { return __builtin_amdgcn_rcpf(1.f + __builtin_amdgcn_exp2f(-1.4426950408889634f * x)); }
DI float silu_f(float x) { return x * sigm_f(x); }

DI int opaque_tid() { int t = threadIdx.x; asm volatile("" : "+v"(t)); return t; }

DI u32x4 gload16_async(const void* base, unsigned byte_off) {
  u32x4 r;
  asm volatile("global_load_dwordx4 %0, %1, %2" : "=v"(r) : "v"(byte_off), "s"(base) : "memory");
  return r;
}
DI void glds16(const void* gptr, unsigned char* ldsptr) {
  __builtin_amdgcn_global_load_lds((const unsigned*)gptr, (__attribute__((address_space(3))) unsigned*)ldsptr, 16, 0, 0);
}
DI void vm_wait0() { asm volatile("s_waitcnt vmcnt(0)" ::: "memory"); }
DI void pin(u32x4& r) { asm volatile("" : "+v"(r)); }

struct SeqInfo { int seq, s, S, tok0; };
DI SeqInfo seq_of(int t) {
  SeqInfo r;
  if (t < TP) { r.seq = t >> 11; r.s = t & 2047; r.S = 2048; r.tok0 = t & ~2047; }
  else { int u = t - TP; r.seq = 8 + (u >> 14); r.s = u & 16383; r.S = 16384; r.tok0 = TP + (u & ~16383); }
  return r;
}

template <int PT, int QT, int WP, int WQ>
DI void gemm_core(f32x16 (&acc)[PT][QT], const u16* __restrict__ Pg, int ldp, const u16* __restrict__ Qg, int ldq, int K,
                  unsigned char* lds, const u16* Pn = nullptr, const u16* Qn = nullptr, bool prologue = true) {
  constexpr int PR = WP * PT * 32, QR = WQ * QT * 32;
  constexpr int NP = PR / 64, NQ = QR / 64;
  constexpr int STAGE = (PR + QR) * 128;
  const int tid = opaque_tid(), lane = tid & 63, wave = tid >> 6;
  const int r = lane & 31, h = lane >> 5;
  const int wp = wave % WP, wq = wave / WP;
  const int lrow = tid >> 3, lc = tid & 7;
  const int gsw = lc ^ ((lrow >> 1) & 7);
  const u16* pgl = Pg + (size_t)lrow * ldp + gsw * 8;
  const u16* qgl = Qg + (size_t)lrow * ldq + gsw * 8;
  unsigned char* lw = lds + tid * 16;
  const int sw = (r >> 1) & 7;
  const int pfa = (wp * PT * 32 + r) * 128 + ((h ^ sw) << 4);
  const int qfa = PR * 128 + (wq * QT * 32 + r) * 128 + ((h ^ sw) << 4);
  const int nk = K >> 6;
  if (prologue) {
#pragma unroll
    for (int i = 0; i < NP; ++i) glds16(pgl + (size_t)i * 64 * ldp, lw + i * 8192);
#pragma unroll
    for (int i = 0; i < NQ; ++i) glds16(qgl + (size_t)i * 64 * ldq, lw + PR * 128 + i * 8192);
    vm_wait0();
    __syncthreads();
  }
  const bool chain = (Pn != nullptr);
#pragma unroll 1
  for (int kt = 0; kt < nk; ++kt) {
    const bool last = (kt + 1 == nk);
    const bool more = !last || chain;
    if (last && chain) {
      pgl = Pn + (size_t)lrow * ldp + gsw * 8 - (size_t)nk * 64;
      qgl = Qn + (size_t)lrow * ldq + gsw * 8 - (size_t)nk * 64;
    }
    const int k0 = (kt + 1) << 6;
    unsigned char* sn = lw + ((kt + 1) & 1) * STAGE;
    const unsigned char* st = lds + (kt & 1) * STAGE;
    bf16x8 pf[2][PT], qf[2][QT];
#pragma unroll
    for (int a = 0; a < PT; ++a) pf[0][a] = *(const bf16x8*)(st + a * 4096 + pfa);
#pragma unroll
    for (int b = 0; b < QT; ++b) qf[0][b] = *(const bf16x8*)(st + b * 4096 + qfa);
#pragma unroll
    for (int ks = 0; ks < 4; ++ks) {
      if (ks < 3) {
#pragma unroll
        for (int a = 0; a < PT; ++a) pf[(ks + 1) & 1][a] = *(const bf16x8*)(st + a * 4096 + (pfa ^ ((ks + 1) << 5)));
#pragma unroll
        for (int b = 0; b < QT; ++b) qf[(ks + 1) & 1][b] = *(const bf16x8*)(st + b * 4096 + (qfa ^ ((ks + 1) << 5)));
      }
      __builtin_amdgcn_sched_barrier(0);
#pragma unroll
      for (int a = 0; a < PT; ++a)
#pragma unroll
        for (int b = 0; b < QT; ++b) {
          acc[a][b] = MFMA(pf[ks & 1][a], qf[ks & 1][b], acc[a][b]);
          const int m = a * QT + b;
          if (m == 0 || m == (PT * QT) / 2) {
            const int j = 2 * ks + (m ? 1 : 0);
            if (more) {
              if (j < NP) glds16(pgl + (size_t)j * 64 * ldp + k0, sn + j * 8192);
              else if (j < NP + NQ) glds16(qgl + (size_t)(j - NP) * 64 * ldq + k0, sn + PR * 128 + (j - NP) * 8192);
            }
            __builtin_amdgcn_sched_barrier(0);
          }
        }
      __builtin_amdgcn_sched_barrier(0);
    }
    vm_wait0();
    __syncthreads();
  }
}

template <int PT, int QT, int WP, int WQ>
DI void stage_acc(const f32x16 (&acc)[PT][QT], unsigned char* img, int cs) {
  const int tid = opaque_tid(), lane = tid & 63, wave = tid >> 6;
  const int r = lane & 31, h = lane >> 5;
  const int wp = wave % WP, wq = wave / WP;
#pragma unroll
  for (int a = 0; a < PT; ++a)
#pragma unroll
    for (int b = 0; b < QT; ++b) {
      const int q = wq * QT * 32 + b * 32 + r;
      const int p0 = wp * PT * 32 + a * 32 + 4 * h;
#pragma unroll
      for (int g = 0; g < 4; ++g) {
        uint2 v;
        v.x = pack2(acc[a][b][4 * g + 0], acc[a][b][4 * g + 1]);
        v.y = pack2(acc[a][b][4 * g + 2], acc[a][b][4 * g + 3]);
        *(uint2*)(img + q * cs + (p0 + 8 * g) * 2) = v;
      }
    }
}

template <int PT, int QT>
DI void zero_acc(f32x16 (&acc)[PT][QT]) {
#pragma unroll
  for (int a = 0; a < PT; ++a)
#pragma unroll
    for (int b = 0; b < QT; ++b)
#pragma unroll
      for (int i = 0; i < 16; ++i) acc[a][b][i] = 0.f;
}


using f32x4 = __attribute__((ext_vector_type(4))) float;
DI int g8_lds_byte(int r, int c) {
  const int st = (r >> 4) * 2 + (c >> 5), rr = r & 15, cc = c & 31, ob = rr * 64 + cc * 2;
  return st * 1024 + (ob ^ (((ob >> 9) & 1) << 5));
}
DI void g8_stage_rc(int b, int& R, int& C) {
  const int st = b / 1024, sb = b % 1024, swz = sb ^ (((sb >> 9) & 1) << 5);
  R = (st >> 1) * 16 + swz / 64; C = (st & 1) * 32 + (swz % 64) / 2;
}
DI void gemm8(f32x4 (&acc)[2][2][4][2], const u16* __restrict__ A, int lda, const u16* __restrict__ Bt, int ldb, int K, unsigned char* shm) {
  const int tid = opaque_tid();
  const int wid = tid >> 6, lane = tid & 63, wr = wid >> 2, wc = wid & 3, fr = lane & 15, fq = lane >> 4;
  int r0, c0, r1, c1;
  g8_stage_rc(tid * 16, r0, c0);
  g8_stage_rc(tid * 16 + 8192, r1, c1);
  const __amdgpu_buffer_rsrc_t srdA = __builtin_amdgcn_make_buffer_rsrc((void*)A, (short)0, 256 * lda * 2, 0x00020000);
  const __amdgpu_buffer_rsrc_t srdB = __builtin_amdgcn_make_buffer_rsrc((void*)Bt, (short)0, 256 * ldb * 2, 0x00020000);
  const unsigned a0o = (unsigned)(r0 * lda + c0) * 2u, a1o = (unsigned)(r1 * lda + c1) * 2u;
  const unsigned b0o = (unsigned)(r0 * ldb + c0) * 2u, b1o = (unsigned)(r1 * ldb + c1) * 2u;
  const unsigned ahalf = 128u * (unsigned)lda * 2u, bhalf = 128u * (unsigned)ldb * 2u;
  const unsigned m0w = (unsigned)(size_t)((LAS_ unsigned char*)shm) + (unsigned)__builtin_amdgcn_readfirstlane(wid) * 1024u;
#define G8_DMA(m0v, voff, srd, soff) asm volatile("s_mov_b32 m0, %0\n\ts_nop 0\n\tbuffer_load_dwordx4 %1, %2, %3 offen lds" \
      :: "s"((unsigned)(m0v)), "v"(voff), "s"(srd), "s"((unsigned)(soff)) : "m0", "memory")
#define G8_SA(b, h) (((b) * 2 + (h)) * 16384)
#define G8_SB(b, h) ((4 + (b) * 2 + (h)) * 16384)
#define G8_STAGE_A(b, h, kt) do { const unsigned g_ = (unsigned)(h) * ahalf + (unsigned)(kt) * 128u; \
    G8_DMA(m0w + G8_SA(b, h), a0o, srdA, g_); G8_DMA(m0w + G8_SA(b, h) + 8192, a1o, srdA, g_); } while (0)
#define G8_STAGE_B(b, h, kt) do { const unsigned g_ = (unsigned)(h) * bhalf + (unsigned)(kt) * 128u; \
    G8_DMA(m0w + G8_SB(b, h), b0o, srdB, g_); G8_DMA(m0w + G8_SB(b, h) + 8192, b1o, srdB, g_); } while (0)
#define G8_LDA(dst, b, h) _Pragma("unroll") for (int m = 0; m < 4; ++m) _Pragma("unroll") for (int k = 0; k < 2; ++k) \
    dst[m][k] = *(const bf16x8*)(shm + G8_SA(b, h) + g8_lds_byte(wr * 64 + m * 16 + fr, k * 32 + fq * 8))
#define G8_LDB(dst, b, h) _Pragma("unroll") for (int n = 0; n < 2; ++n) _Pragma("unroll") for (int k = 0; k < 2; ++k) \
    dst[n][k] = *(const bf16x8*)(shm + G8_SB(b, h) + g8_lds_byte(wc * 32 + n * 16 + fr, k * 32 + fq * 8))
#define G8_MMA(ai, bj, At_, Bt_) do { __builtin_amdgcn_s_setprio(1); \
    _Pragma("unroll") for (int m = 0; m < 4; ++m) _Pragma("unroll") for (int n = 0; n < 2; ++n) _Pragma("unroll") for (int k = 0; k < 2; ++k) \
      acc[ai][bj][m][n] = __builtin_amdgcn_mfma_f32_16x16x32_bf16(At_[m][k], Bt_[n][k], acc[ai][bj][m][n], 0, 0, 0); \
    __builtin_amdgcn_s_setprio(0); } while (0)
#define G8_WAIT_V(n) asm volatile("s_waitcnt vmcnt(" #n ")" ::: "memory")
#define G8_WAIT_L(n) asm volatile("s_waitcnt lgkmcnt(" #n ")" ::: "memory")
#define G8_BAR __builtin_amdgcn_s_barrier()
#define G8_SCHED __builtin_amdgcn_sched_barrier(0)
  bf16x8 At[4][2], B0[2][2], B1[2][2];
  const int nt = K / 64;
  G8_STAGE_B(0, 0, 0); G8_STAGE_A(0, 0, 0);
  G8_STAGE_B(0, 1, 0); G8_STAGE_A(0, 1, 0);
  if (wr == 1) G8_BAR;
  G8_WAIT_V(4); G8_BAR;
  G8_STAGE_B(1, 0, 1); G8_STAGE_A(1, 0, 1); G8_STAGE_B(1, 1, 1);
  G8_WAIT_V(6); G8_BAR;
#pragma unroll 1
  for (int t = 0; t < nt - 2; t += 2) {
    G8_LDB(B0, 0, 0); G8_SCHED; G8_LDA(At, 0, 0); G8_STAGE_A(1, 1, t + 1);
    G8_WAIT_L(8); G8_BAR; G8_WAIT_L(0); G8_MMA(0, 0, At, B0); G8_BAR; G8_SCHED;
    G8_LDB(B1, 0, 1); G8_STAGE_B(0, 0, t + 2);
    G8_BAR; G8_WAIT_L(0); G8_MMA(0, 1, At, B1); G8_BAR;
    G8_LDA(At, 0, 1); G8_STAGE_A(0, 0, t + 2);
    G8_BAR; G8_WAIT_L(0); G8_MMA(1, 0, At, B0); G8_BAR; G8_SCHED;
    G8_STAGE_B(0, 1, t + 2);
    G8_WAIT_V(6); G8_BAR; G8_MMA(1, 1, At, B1); G8_BAR;
    G8_LDB(B0, 1, 0); G8_SCHED; G8_LDA(At, 1, 0); G8_STAGE_A(0, 1, t + 2);
    G8_WAIT_L(8); G8_BAR; G8_WAIT_L(0); G8_MMA(0, 0, At, B0); G8_BAR; G8_SCHED;
    G8_LDB(B1, 1, 1); G8_STAGE_B(1, 0, t + 3);
    G8_BAR; G8_WAIT_L(0); G8_MMA(0, 1, At, B1); G8_BAR;
    G8_LDA(At, 1, 1); G8_STAGE_A(1, 0, t + 3);
    G8_BAR; G8_WAIT_L(0); G8_MMA(1, 0, At, B0); G8_BAR; G8_SCHED;
    G8_STAGE_B(1, 1, t + 3);
    G8_WAIT_V(6); G8_BAR; G8_MMA(1, 1, At, B1); G8_BAR;
  }
  { G8_LDB(B0, 0, 0); G8_LDA(At, 0, 0); G8_STAGE_A(1, 1, nt - 1);
    G8_BAR; G8_WAIT_L(0); G8_MMA(0, 0, At, B0); G8_BAR;
    G8_LDB(B1, 0, 1); G8_BAR; G8_WAIT_L(0); G8_MMA(0, 1, At, B1); G8_BAR;
    G8_LDA(At, 0, 1); G8_WAIT_V(4); G8_BAR; G8_WAIT_L(0); G8_MMA(1, 0, At, B0); G8_MMA(1, 1, At, B1); G8_BAR; }
  { G8_LDB(B0, 1, 0); G8_LDA(At, 1, 0); G8_WAIT_V(2); G8_BAR; G8_WAIT_L(0); G8_MMA(0, 0, At, B0); G8_BAR;
    G8_LDB(B1, 1, 1); G8_WAIT_V(0); G8_BAR; G8_WAIT_L(0); G8_MMA(0, 1, At, B1); G8_BAR;
    G8_LDA(At, 1, 1); G8_BAR; G8_WAIT_L(0); G8_MMA(1, 0, At, B0); G8_MMA(1, 1, At, B1); G8_BAR; }
  if (wr == 0) G8_BAR;
}

DI void stage_acc8(const f32x4 (&acc)[2][2][4][2], unsigned char* img, int cs) {
  const int tid = opaque_tid();
  const int wid = tid >> 6, lane = tid & 63, wr = wid >> 2, wc = wid & 3, fr = lane & 15, fq = lane >> 4;
#pragma unroll
  for (int ai = 0; ai < 2; ++ai)
#pragma unroll
    for (int bj = 0; bj < 2; ++bj)
#pragma unroll
      for (int m = 0; m < 4; ++m)
#pragma unroll
        for (int n = 0; n < 2; ++n) {
          const int q = bj * 128 + wc * 32 + n * 16 + fr;
          const int p = ai * 128 + wr * 64 + m * 16 + fq * 4;
          uint2 v;
          v.x = pack2(acc[ai][bj][m][n][0], acc[ai][bj][m][n][1]);
          v.y = pack2(acc[ai][bj][m][n][2], acc[ai][bj][m][n][3]);
          *(uint2*)(img + q * cs + p * 2) = v;
        }
}
DI void zero_acc8(f32x4 (&acc)[2][2][4][2]) {
#pragma unroll
  for (int ai = 0; ai < 2; ++ai)
#pragma unroll
    for (int bj = 0; bj < 2; ++bj)
#pragma unroll
      for (int m = 0; m < 4; ++m)
#pragma unroll
        for (int n = 0; n < 2; ++n) acc[ai][bj][m][n] = (f32x4){0.f, 0.f, 0.f, 0.f};
}

DI void phase0a(const Params& p, unsigned char* lds) {
  const int tid = threadIdx.x;
  float* modb = (float*)(p.ws + WS_MOD);
  if (blockIdx.x == 0 && tid == 0) {
    float s1 = 0.f, s2 = 0.f, mq = 0.f, mk = 0.f;
    for (int i = 0; i < 64; ++i) {
      s1 += p.lq1[i] * p.lk1[i];
      s2 += p.lq2[i] * p.lk2[i];
      mq = fmaxf(mq, fabsf(p.qg[i]));
      mk = fmaxf(mk, fabsf(p.kg[i]));
    }
    modb[30720] = __expf(s1) - __expf(s2) + 0.2f;
    modb[30721] = -(8.f * 1.4426950408889634f * mq * mk);
  }
  for (int it = blockIdx.x; it < 192; it += gridDim.x) {
    float* sc = (float*)lds;
    float* red = (float*)(lds + 40960);
    for (int i = tid; i < 10240; i += NT) {
      const int b = i >> 10, k = i & 1023;
      const float c = (b < 8) ? p.c_p[b * 1024 + k] : p.c_s[(b - 8) * 1024 + k];
      sc[i] = silu_f(c);
    }
    __syncthreads();
    const int cl = tid & 15, ks = tid >> 4;
    const int col = it * 16 + cl;
    float a[10];
#pragma unroll
    for (int b = 0; b < 10; ++b) a[b] = 0.f;
#pragma unroll 8
    for (int kk = 0; kk < 32; ++kk) {
      const int k = ks * 32 + kk;
      const float w = p.w_ada[(size_t)k * 3072 + col];
#pragma unroll
      for (int b = 0; b < 10; ++b) a[b] += sc[b * 1024 + k] * w;
    }
#pragma unroll
    for (int b = 0; b < 10; ++b) red[ks * 160 + cl * 10 + b] = a[b];
    __syncthreads();
    if (tid < 160) {
      const int c = tid / 10, b = tid % 10;
      float s = 0.f;
      for (int j = 0; j < 32; ++j) s += red[j * 160 + c * 10 + b];
      modb[b * 3072 + it * 16 + c] = s + p.b_ada[it * 16 + c];
    }
    __syncthreads();
  }
}

DI void weight_transposes(const Params& p, unsigned char* lds) {
  const int tid = threadIdx.x;
  for (int it = blockIdx.x; it < 2048; it += gridDim.x) {
    const float* src; u16* dst; int K, N, kt, nt; bool perm = false;
    if (it < 1536) { src = p.w_in; dst = (u16*)(p.ws + WS_WIN); K = 1024; N = 6144; kt = it / 96; nt = it % 96; perm = true; }
    else if (it < 1664) { int j = it - 1536; src = p.wc; dst = (u16*)(p.ws + WS_WC); K = 512; N = 1024; kt = j / 16; nt = j % 16; }
    else if (it < 1792) { int j = it - 1664; src = p.wa; dst = (u16*)(p.ws + WS_WA); K = 512; N = 1024; kt = j / 16; nt = j % 16; }
    else { int j = it - 1792; src = p.wo; dst = (u16*)(p.ws + WS_WO); K = 1024; N = 1024; kt = j / 16; nt = j % 16; }
    float* tl = (float*)lds;
    const int k0 = kt * 64, n0 = nt * 64;
#pragma unroll
    for (int i = 0; i < 8; ++i) {
      const int k = i * 8 + (tid >> 6), n = tid & 63;
      tl[k * 65 + n] = src[(size_t)(k0 + k) * N + n0 + n];
    }
    __syncthreads();
    {
      const int n = tid >> 3, kc = (tid & 7) * 8;
      float v[8];
#pragma unroll
      for (int j = 0; j < 8; ++j) v[j] = tl[(kc + j) * 65 + n];
      int nn = n0 + n;
      if (perm && nn < 2048) { const int part = nn >> 9, ch = nn & 511; nn = (ch >> 6) * 256 + part * 64 + (ch & 63); }
      uint4 o;
      o.x = pack2(v[0], v[1]); o.y = pack2(v[2], v[3]); o.z = pack2(v[4], v[5]); o.w = pack2(v[6], v[7]);
      *(uint4*)(dst + (size_t)nn * K + k0 + kc) = o;
    }
    __syncthreads();
  }
}

DI void phase0b(const Params& p, unsigned char* lds) {
  weight_transposes(p, lds);
  const int tid = threadIdx.x, lane = tid & 63, wave = tid >> 6;
  const float* modb = (const float*)(p.ws + WS_MOD);
  u16* hb = (u16*)(p.ws + WS_H);
  for (int t = blockIdx.x * 8 + wave; t < T; t += gridDim.x * 8) {
    const float* xr = (t < TP) ? p.x_p + (size_t)t * 1024 : p.x_s + (size_t)(t - TP) * 1024;
    const int seq = (t < TP) ? (t >> 11) : 8 + ((t - TP) >> 14);
    float4 v[4];
    float ss = 0.f;
#pragma unroll
    for (int i = 0; i < 4; ++i) {
      v[i] = *(const float4*)(xr + i * 256 + lane * 4);
      ss += v[i].x * v[i].x + v[i].y * v[i].y + v[i].z * v[i].z + v[i].w * v[i].w;
    }
#pragma unroll
    for (int o = 32; o > 0; o >>= 1) ss += __shfl_xor(ss, o);
    const float rstd = rsqrtf(ss * (1.f / 1024.f) + 1e-6f);
    const float* sh = modb + seq * 3072;
#pragma unroll
    for (int i = 0; i < 4; ++i) {
      const int c = i * 256 + lane * 4;
      const float4 g = *(const float4*)(p.norm_g + c);
      const float4 shf = *(const float4*)(sh + c);
      const float4 scl = *(const float4*)(sh + 1024 + c);
      const float y0 = v[i].x * rstd * g.x * (1.f + scl.x) + shf.x;
      const float y1 = v[i].y * rstd * g.y * (1.f + scl.y) + shf.y;
      const float y2 = v[i].z * rstd * g.z * (1.f + scl.z) + shf.z;
      const float y3 = v[i].w * rstd * g.w * (1.f + scl.w) + shf.w;
      uint2 o;
      o.x = pack2(y0, y1); o.y = pack2(y2, y3);
      *(uint2*)(hb + (size_t)t * 1024 + c) = o;
    }
  }
}

DI void qk_epilogue(const Params& p, const unsigned char* img, int tokm, int nt) {
  const int tid = opaque_tid();
  const bool isq = nt < 10;
  const float* gain = isq ? p.qg : p.kg;
  u16* dstb = (u16*)(p.ws + (isq ? WS_Q : WS_K));
  const float osc = isq ? (0.125f * 1.4426950408889634f) : 1.f;
  const int hb = ((nt - 8) & 1) * 2;
#pragma unroll 1
  for (int i = 0; i < 2; ++i) {
    const int id = tid + NT * i;
    const int row = id >> 2, grp = id & 3;
    const unsigned char* rp = img + row * 528 + grp * 128;
    float v[64];
    float ss = 0.f;
#pragma unroll
    for (int j = 0; j < 8; ++j) {
      const uint4 w = *(const uint4*)(rp + j * 16);
      v[8 * j + 0] = bflo(w.x); v[8 * j + 1] = bfhi(w.x); v[8 * j + 2] = bflo(w.y); v[8 * j + 3] = bfhi(w.y);
      v[8 * j + 4] = bflo(w.z); v[8 * j + 5] = bfhi(w.z); v[8 * j + 6] = bflo(w.w); v[8 * j + 7] = bfhi(w.w);
    }
#pragma unroll
    for (int d = 0; d < 64; ++d) ss += v[d] * v[d];
    const float rstd = rsqrtf(ss * (1.f / 64.f) + 1e-6f);
#pragma unroll
    for (int d = 0; d < 64; ++d) v[d] = v[d] * rstd * gain[d];
    const SeqInfo si = seq_of(tokm + row);
#pragma unroll
    for (int j = 0; j < 8; ++j) {
      double fr = (double)si.s * p.invf[j];
      fr -= rint(fr);
      const float ff = (float)fr;
      const float sn = __builtin_amdgcn_sinf(ff), cs = __builtin_amdgcn_cosf(ff);
      const float x1 = v[j], x2 = v[j + 8];
      v[j] = x1 * cs - x2 * sn;
      v[j + 8] = x2 * cs + x1 * sn;
    }
    const int head = hb + (grp >> 1), c = grp & 1;
    u16* dst = dstb + (size_t)si.tok0 * 512 + ((size_t)(head * 2 + c) * si.S + si.s) * 64;
#pragma unroll
    for (int j = 0; j < 8; ++j) {
      uint4 o;
      o.x = pack2(v[8 * j + 0] * osc, v[8 * j + 1] * osc); o.y = pack2(v[8 * j + 2] * osc, v[8 * j + 3] * osc);
      o.z = pack2(v[8 * j + 4] * osc, v[8 * j + 5] * osc); o.w = pack2(v[8 * j + 6] * osc, v[8 * j + 7] * osc);
      *(uint4*)(dst + j * 8) = o;
    }
  }
}

DI void phase1(const Params& p, unsigned char* lds) {
  const u16* hb = (const u16*)(p.ws + WS_H);
  const u16* win = (const u16*)(p.ws + WS_WIN);
  const bool xcd_map = (gridDim.x == 256);
  for (int t = blockIdx.x, it = 0; t < 192 * 24; t += gridDim.x, ++it) {
    int nt = t % 24, mt = t / 24;
    if (xcd_map) {
      const int x = blockIdx.x & 7, j = blockIdx.x >> 3;
      mt = x * 24 + (it / 3) * 4 + (j & 3);
      nt = (it % 3) * 8 + (j >> 2);
    }
    const int tokm = mt * 256;
    const u16* Hg = hb + (size_t)tokm * 1024;
    const u16* Wg = win + (size_t)nt * 256 * 1024;
    const bool vmode = (nt == 12 || nt == 13);
    f32x4 acc[2][2][4][2];
    zero_acc8(acc);
    gemm8(acc, vmode ? Hg : Wg, 1024, vmode ? Wg : Hg, 1024, 1024, lds);
    __syncthreads();
    stage_acc8(acc, lds, 528);
    __syncthreads();
    const int tid = opaque_tid();
    if (nt < 8) {
      u16* Y = (u16*)(p.ws + WS_G);
      u16* UB = (u16*)(p.ws + WS_U);
      u16* GB = (u16*)(p.ws + WS_U + (1u << 20));
      const int mt_ = tokm >> 8;
#pragma unroll 1
      for (int i = 0; i < 4; ++i) {
        const int id = tid + NT * i;
        const int row = id >> 3, j = id & 7;
        const unsigned char* rp = lds + row * 528 + j * 16;
        const uint4 vb = *(const uint4*)(rp), vc = *(const uint4*)(rp + 128), vx = *(const uint4*)(rp + 256), vz = *(const uint4*)(rp + 384);
        float u0[8], g[8];
        u0[0] = bflo(vc.x) * bflo(vx.x); u0[1] = bfhi(vc.x) * bfhi(vx.x); u0[2] = bflo(vc.y) * bflo(vx.y); u0[3] = bfhi(vc.y) * bfhi(vx.y);
        u0[4] = bflo(vc.z) * bflo(vx.z); u0[5] = bfhi(vc.z) * bfhi(vx.z); u0[6] = bflo(vc.w) * bflo(vx.w); u0[7] = bfhi(vc.w) * bfhi(vx.w);
        g[0] = bflo(vb.x) * silu_f(bflo(vz.x)); g[1] = bfhi(vb.x) * silu_f(bfhi(vz.x)); g[2] = bflo(vb.y) * silu_f(bflo(vz.y)); g[3] = bfhi(vb.y) * silu_f(bfhi(vz.y));
        g[4] = bflo(vb.z) * silu_f(bflo(vz.z)); g[5] = bfhi(vb.z) * silu_f(bfhi(vz.z)); g[6] = bflo(vb.w) * silu_f(bflo(vz.w)); g[7] = bfhi(vb.w) * silu_f(bfhi(vz.w));
        const int ch0 = nt * 64 + j * 8;
        if (row == 0 || row == 255) {
          uint4 go, uo;
          go.x = pack2(g[0], g[1]); go.y = pack2(g[2], g[3]); go.z = pack2(g[4], g[5]); go.w = pack2(g[6], g[7]);
          uo.x = pack2(u0[0], u0[1]); uo.y = pack2(u0[2], u0[3]); uo.z = pack2(u0[4], u0[5]); uo.w = pack2(u0[6], u0[7]);
          *(uint4*)(GB + ((size_t)mt_ * 2 + (row ? 1 : 0)) * 512 + ch0) = go;
          *(uint4*)(UB + ((size_t)mt_ * 4 + (row ? 3 : 0)) * 512 + ch0) = uo;
        } else {
          const uint4 pc = *(const uint4*)(rp - 528 + 128), px = *(const uint4*)(rp - 528 + 256);
          const uint4 nc = *(const uint4*)(rp + 528 + 128), nx = *(const uint4*)(rp + 528 + 256);
          float um[8], up[8];
          um[0] = bflo(pc.x) * bflo(px.x); um[1] = bfhi(pc.x) * bfhi(px.x); um[2] = bflo(pc.y) * bflo(px.y); um[3] = bfhi(pc.y) * bfhi(px.y);
          um[4] = bflo(pc.z) * bflo(px.z); um[5] = bfhi(pc.z) * bfhi(px.z); um[6] = bflo(pc.w) * bflo(px.w); um[7] = bfhi(pc.w) * bfhi(px.w);
          up[0] = bflo(nc.x) * bflo(nx.x); up[1] = bfhi(nc.x) * bfhi(nx.x); up[2] = bflo(nc.y) * bflo(nx.y); up[3] = bfhi(nc.y) * bfhi(nx.y);
          up[4] = bflo(nc.z) * bflo(nx.z); up[5] = bfhi(nc.z) * bfhi(nx.z); up[6] = bflo(nc.w) * bflo(nx.w); up[7] = bfhi(nc.w) * bfhi(nx.w);
          const float4 wa0 = *(const float4*)(p.conv_w + ch0), wa1 = *(const float4*)(p.conv_w + ch0 + 4);
          const float4 wb0 = *(const float4*)(p.conv_w + 512 + ch0), wb1 = *(const float4*)(p.conv_w + 512 + ch0 + 4);
          const float4 wc0 = *(const float4*)(p.conv_w + 1024 + ch0), wc1 = *(const float4*)(p.conv_w + 1024 + ch0 + 4);
          const float w0[8] = {wa0.x, wa0.y, wa0.z, wa0.w, wa1.x, wa1.y, wa1.z, wa1.w};
          const float w1[8] = {wb0.x, wb0.y, wb0.z, wb0.w, wb1.x, wb1.y, wb1.z, wb1.w};
          const float w2[8] = {wc0.x, wc0.y, wc0.z, wc0.w, wc1.x, wc1.y, wc1.z, wc1.w};
          float y[8];
#pragma unroll
          for (int e = 0; e < 8; ++e) y[e] = g[e] * (w0[e] * um[e] + w1[e] * u0[e] + w2[e] * up[e]);
          uint4 yo;
          yo.x = pack2(y[0], y[1]); yo.y = pack2(y[2], y[3]); yo.z = pack2(y[4], y[5]); yo.w = pack2(y[6], y[7]);
          *(uint4*)(Y + (size_t)(tokm + row) * 512 + ch0) = yo;
          if (row == 1 || row == 254) {
            uint4 uo;
            uo.x = pack2(u0[0], u0[1]); uo.y = pack2(u0[2], u0[3]); uo.z = pack2(u0[4], u0[5]); uo.w = pack2(u0[6], u0[7]);
            *(uint4*)(UB + ((size_t)mt_ * 4 + (row == 1 ? 1 : 2)) * 512 + ch0) = uo;
          }
        }
      }
    } else if (nt < 12) {
      qk_epilogue(p, lds, tokm, nt);
    } else if (nt < 14) {
      u16* VT = (u16*)(p.ws + WS_V);
      const SeqInfo si = seq_of(tokm);
#pragma unroll
      for (int i = 0; i < 16; ++i) {
        const int id = tid + NT * i;
        const int row = id >> 5, ch = id & 31;
        const uint4 v = *(const uint4*)(lds + row * 528 + ch * 16);
        const int hd = (nt - 12) * 256 + row;
        *(uint4*)(VT + (size_t)si.tok0 * 512 + (size_t)hd * si.S + si.s + ch * 8) = v;
      }
    } else {
      u16* dstb; int ld, c0;
      if (nt < 16) { dstb = (u16*)(p.ws + WS_AZ); ld = 512; c0 = (nt - 14) * 256; }
      else { dstb = (u16*)p.out; ld = 2048; c0 = (nt - 16) * 256; }
#pragma unroll
      for (int i = 0; i < 16; ++i) {
        const int id = tid + NT * i;
        const int row = id >> 5, ch = id & 31;
        const uint4 v = *(const uint4*)(lds + row * 528 + ch * 16);
        *(uint4*)(dstb + (size_t)(tokm + row) * ld + c0 + ch * 8) = v;
      }
    }
    asm volatile("s_waitcnt lgkmcnt(0)" ::: "memory");
    __builtin_amdgcn_s_barrier();
  }
}

DI void conv_pass(const Params& p) {
  const u16* UB = (const u16*)(p.ws + WS_U);
  const u16* GB = (const u16*)(p.ws + WS_U + (1u << 20));
  u16* Y = (u16*)(p.ws + WS_G);
  const int total = 192 * 2 * 64;
  for (int id = blockIdx.x * NT + threadIdx.x; id < total; id += gridDim.x * NT) {
    const int c8 = (id & 63) * 8, hi = (id >> 6) & 1, k = id >> 7;
    const int t = k * 256 + (hi ? 255 : 0);
    const SeqInfo si = seq_of(t);
    int rm = hi ? (k * 4 + 2) : ((k - 1) * 4 + 3);
    int rq = hi ? ((k + 1) * 4 + 0) : (k * 4 + 1);
    const bool vm_ = hi || (si.s > 0), vp_ = !hi || (si.s < si.S - 1);
    if (!vm_) rm = k * 4;
    if (!vp_) rq = k * 4 + 3;
    const float fm = vm_ ? 1.f : 0.f, fp = vp_ ? 1.f : 0.f;
    const uint4 um = *(const uint4*)(UB + (size_t)rm * 512 + c8);
    const uint4 u0 = *(const uint4*)(UB + ((size_t)k * 4 + (hi ? 3 : 0)) * 512 + c8);
    const uint4 up = *(const uint4*)(UB + (size_t)rq * 512 + c8);
    const uint4 g = *(const uint4*)(GB + ((size_t)k * 2 + hi) * 512 + c8);
    float4 wa0 = *(const float4*)(p.conv_w + c8), wa1 = *(const float4*)(p.conv_w + c8 + 4);
    const float4 wb0 = *(const float4*)(p.conv_w + 512 + c8), wb1 = *(const float4*)(p.conv_w + 512 + c8 + 4);
    float4 wc0 = *(const float4*)(p.conv_w + 1024 + c8), wc1 = *(const float4*)(p.conv_w + 1024 + c8 + 4);
    wa0.x *= fm; wa0.y *= fm; wa0.z *= fm; wa0.w *= fm; wa1.x *= fm; wa1.y *= fm; wa1.z *= fm; wa1.w *= fm;
    wc0.x *= fp; wc0.y *= fp; wc0.z *= fp; wc0.w *= fp; wc1.x *= fp; wc1.y *= fp; wc1.z *= fp; wc1.w *= fp;
    uint4 y;
    y.x = pack2(bflo(g.x) * (wa0.x * bflo(um.x) + wb0.x * bflo(u0.x) + wc0.x * bflo(up.x)),
                bfhi(g.x) * (wa0.y * bfhi(um.x) + wb0.y * bfhi(u0.x) + wc0.y * bfhi(up.x)));
    y.y = pack2(bflo(g.y) * (wa0.z * bflo(um.y) + wb0.z * bflo(u0.y) + wc0.z * bflo(up.y)),
                bfhi(g.y) * (wa0.w * bfhi(um.y) + wb0.w * bfhi(u0.y) + wc0.w * bfhi(up.y)));
    y.z = pack2(bflo(g.z) * (wa1.x * bflo(um.z) + wb1.x * bflo(u0.z) + wc1.x * bflo(up.z)),
                bfhi(g.z) * (wa1.y * bfhi(um.z) + wb1.y * bfhi(u0.z) + wc1.y * bfhi(up.z)));
    y.w = pack2(bflo(g.w) * (wa1.z * bflo(um.w) + wb1.z * bflo(u0.w) + wc1.z * bflo(up.w)),
                bfhi(g.w) * (wa1.w * bfhi(um.w) + wb1.w * bfhi(u0.w) + wc1.w * bfhi(up.w)));
    *(uint4*)(Y + (size_t)t * 512 + c8) = y;
  }
}

DI void attn_item(const Params& p, int item, unsigned char* lds, float lam) {
  const int tid = opaque_tid(), lane = tid & 63, wave = __builtin_amdgcn_readfirstlane(tid >> 6);
  const int r = lane & 31, h = lane >> 5;
  int tok0, S, head, qb;
  if (item < 512) {
    const int combo = item & 7; qb = item >> 3;
    tok0 = TP + (combo >> 2) * 16384; head = combo & 3; S = 16384;
  } else {
    const int j = item - 512; const int x = j & 7, jj = j >> 3;
    const int combo = x * 4 + (jj & 3); qb = jj >> 2;
    tok0 = (combo >> 2) * 2048; head = combo & 3; S = 2048;
  }
  const u16* Qb = (const u16*)(p.ws + WS_Q) + (size_t)tok0 * 512;
  const u16* Kb = (const u16*)(p.ws + WS_K) + (size_t)tok0 * 512;
  const u16* Vb = (const u16*)(p.ws + WS_V) + (size_t)tok0 * 512 + (size_t)head * 128 * S;
  const u16* K1g = Kb + (size_t)(head * 2 + 0) * S * 64;
  const u16* K2g = Kb + (size_t)(head * 2 + 1) * S * 64;
  const int qrow = qb * 256 + wave * 32 + r;
  unsigned char* qlds = lds + 65536 + wave * 8192;
  {
    const u16* qg0 = Qb + ((size_t)(head * 2) * S + qb * 256 + wave * 32) * 64;
#pragma unroll
    for (int i = 0; i < 8; ++i) {
      const int id = lane + 64 * i;
      const int c = id >> 8, row = (id >> 3) & 31, ch = id & 7;
      const uint4 v = *(const uint4*)(qg0 + ((size_t)c * S + row) * 64 + ch * 8);
      *(uint4*)(qlds + c * 4096 + row * 128 + ((ch ^ ((row >> 1) & 7)) << 4)) = v;
    }
  }
  f32x16 O1[4], O2[4];
#pragma unroll
  for (int a = 0; a < 4; ++a)
#pragma unroll
    for (int i = 0; i < 16; ++i) { O1[a][i] = 0.f; O2[a][i] = 0.f; }
  float l1 = 0.f, l2 = 0.f;

  const int lrow = tid >> 3, lc = tid & 7;
  const int gsw = lc ^ ((lrow >> 1) & 7);
  const __amdgpu_buffer_rsrc_t srdK1 = __builtin_amdgcn_make_buffer_rsrc((void*)K1g, (short)0, S * 128, 0x00020000);
  const __amdgpu_buffer_rsrc_t srdK2 = __builtin_amdgcn_make_buffer_rsrc((void*)K2g, (short)0, S * 128, 0x00020000);
  const __amdgpu_buffer_rsrc_t srdV = __builtin_amdgcn_make_buffer_rsrc((void*)Vb, (short)0, S * 256, 0x00020000);
  const unsigned kvo = (lrow * 64 + gsw * 8) * 2;
  const unsigned vvo = (lrow * S + gsw * 8) * 2;
  const unsigned m0w = (unsigned)(size_t)((LAS_ unsigned char*)lds) + wave * 1024;
#define AT_DMA(m0v, voff, srd, soff) asm volatile("s_mov_b32 m0, %0\n\ts_nop 0\n\tbuffer_load_dwordx4 %1, %2, %3 offen lds" \
      :: "s"((unsigned)(m0v)), "v"(voff), "s"(srd), "s"((unsigned)(soff)) : "m0", "memory")
  const int kr = (r & 19) | ((r & 4) << 1) | ((r & 8) >> 1);
  const int ksw = (kr >> 1) & 7;
  const int vsw = (r >> 1) & 7;
  const int ka0 = kr * 128 + ((h ^ ksw) << 4);
  const int qa0 = r * 128 + ((h ^ vsw) << 4);
  const int vfa = 16384 + r * 128;

  AT_DMA(m0w, kvo, srdK1, 0u); AT_DMA(m0w + 8192u, kvo, srdK2, 0u);
  AT_DMA(m0w + 16384u, vvo, srdV, 0u); AT_DMA(m0w + 24576u, vvo, srdV, (unsigned)S * 128u);
  vm_wait0();
  __syncthreads();
  const int nkt = S >> 6;
#pragma unroll 1
  for (int kt = 0; kt < nkt; ++kt) {
    if (kt + 1 < nkt) {
      const unsigned key0 = (unsigned)(kt + 1) << 6;
      const unsigned mn = m0w + (unsigned)((kt + 1) & 1) * 32768u;
      AT_DMA(mn, kvo, srdK1, key0 * 128u); AT_DMA(mn + 8192u, kvo, srdK2, key0 * 128u);
      AT_DMA(mn + 16384u, vvo, srdV, key0 * 2u); AT_DMA(mn + 24576u, vvo, srdV, key0 * 2u + (unsigned)S * 128u);
    }
    const unsigned char* st = lds + (kt & 1) * 32768;
#pragma unroll
    for (int kb = 0; kb < 2; ++kb) {
      f32x16 s1, s2;
#pragma unroll
      for (int i = 0; i < 16; ++i) { s1[i] = 0.f; s2[i] = 0.f; }
#pragma unroll
      for (int ks = 0; ks < 4; ++ks) {
        const bf16x8 a1 = *(const bf16x8*)(st + kb * 4096 + (ka0 ^ (ks << 5)));
        const bf16x8 b1 = *(const bf16x8*)(qlds + (qa0 ^ (ks << 5)));
        s1 = MFMA(a1, b1, s1);
        const bf16x8 a2 = *(const bf16x8*)(st + 8192 + kb * 4096 + (ka0 ^ (ks << 5)));
        const bf16x8 b2 = *(const bf16x8*)(qlds + 4096 + (qa0 ^ (ks << 5)));
        s2 = MFMA(a2, b2, s2);
      }
      unsigned pb1[8], pb2[8];
#pragma unroll
      for (int i = 0; i < 8; ++i) {
        const float e0 = __builtin_amdgcn_exp2f(s1[2 * i]), e1 = __builtin_amdgcn_exp2f(s1[2 * i + 1]);
        l1 += e0 + e1;
        pb1[i] = pack2(e0, e1);
        const float f0 = __builtin_amdgcn_exp2f(s2[2 * i]), f1 = __builtin_amdgcn_exp2f(s2[2 * i + 1]);
        l2 += f0 + f1;
        pb2[i] = pack2(f0, f1);
      }
#pragma unroll
      for (int s = 0; s < 2; ++s) {
        bf16x8 b1, b2;
        {
          uint4 t1 = {pb1[4 * s], pb1[4 * s + 1], pb1[4 * s + 2], pb1[4 * s + 3]};
          uint4 t2 = {pb2[4 * s], pb2[4 * s + 1], pb2[4 * s + 2], pb2[4 * s + 3]};
          b1 = __builtin_bit_cast(bf16x8, t1);
          b2 = __builtin_bit_cast(bf16x8, t2);
        }
        const int vo = ((kb * 4 + 2 * s + h) ^ vsw) << 4;
#pragma unroll
        for (int dvt = 0; dvt < 4; ++dvt) {
          const bf16x8 vf = *(const bf16x8*)(st + vfa + dvt * 4096 + vo);
          O1[dvt] = MFMA(vf, b1, O1[dvt]);
          O2[dvt] = MFMA(vf, b2, O2[dvt]);
        }
      }
    }
    vm_wait0();
    __syncthreads();
  }
#undef AT_DMA
  l1 += __shfl_xor(l1, 32);
  l2 += __shfl_xor(l2, 32);
  const float i1 = 1.f / l1, i2 = lam / l2;
  float ss = 0.f;
#pragma unroll
  for (int a = 0; a < 4; ++a)
#pragma unroll
    for (int i = 0; i < 16; ++i) {
      const float o = O1[a][i] * i1 - O2[a][i] * i2;
      O1[a][i] = o;
      ss += o * o;
    }
  ss += __shfl_xor(ss, 32);
  const float rstd = rsqrtf(ss * (1.f / 128.f) + 1e-6f) * 0.8f;
  const size_t tok = (size_t)tok0 + qrow;
  const u16* azr = (const u16*)(p.ws + WS_AZ) + tok * 512 + head * 128;
  u16* orow = (u16*)(p.ws + WS_O) + tok * 512 + head * 128;
#pragma unroll
  for (int a = 0; a < 4; ++a)
#pragma unroll
    for (int g = 0; g < 4; ++g) {
      __builtin_amdgcn_sched_barrier(0);
      const int dv0 = a * 32 + 8 * g + 4 * h;
      const uint2 az = *(const uint2*)(azr + dv0);
      const float4 sg = *(const float4*)(p.subln + dv0);
      const float y0 = O1[a][4 * g + 0] * rstd * sg.x * silu_f(bflo(az.x));
      const float y1 = O1[a][4 * g + 1] * rstd * sg.y * silu_f(bfhi(az.x));
      const float y2 = O1[a][4 * g + 2] * rstd * sg.z * silu_f(bflo(az.y));
      const float y3 = O1[a][4 * g + 3] * rstd * sg.w * silu_f(bfhi(az.y));
      uint2 o;
      o.x = pack2(y0, y1); o.y = pack2(y2, y3);
      *(uint2*)(orow + dv0) = o;
    }
}

DI void phase2(const Params& p, unsigned char* lds) {
  conv_pass(p);
  const float* modb = (const float*)(p.ws + WS_MOD);
  const float lam = modb[30720];
  for (int rep = 0; rep < 1 + ((REPM >> 3) & 1); ++rep)
    for (int item = blockIdx.x; item < 768; item += gridDim.x) attn_item(p, item, lds, lam);
}

DI void load_acc8(f32x4 (&acc)[2][2][4][2], const unsigned char* img, int cs) {
  const int tid = opaque_tid();
  const int wid = tid >> 6, lane = tid & 63, wr = wid >> 2, wc = wid & 3, fr = lane & 15, fq = lane >> 4;
#pragma unroll
  for (int ai = 0; ai < 2; ++ai)
#pragma unroll
    for (int bj = 0; bj < 2; ++bj)
#pragma unroll
      for (int m = 0; m < 4; ++m)
#pragma unroll
        for (int n = 0; n < 2; ++n) {
          const int q = bj * 128 + wc * 32 + n * 16 + fr;
          const int pp = ai * 128 + wr * 64 + m * 16 + fq * 4;
          const uint2 v = *(const uint2*)(img + q * cs + pp * 2);
          acc[ai][bj][m][n] = (f32x4){bflo(v.x), bfhi(v.x), bflo(v.y), bfhi(v.y)};
        }
}

DI void phase3a(const Params& p, unsigned char* lds) {
  const u16* Y = (const u16*)(p.ws + WS_G);
  const u16* O = (const u16*)(p.ws + WS_O);
  const u16* WC = (const u16*)(p.ws + WS_WC);
  const u16* WA = (const u16*)(p.ws + WS_WA);
  const u16* GAB = (const u16*)p.out;
  u16* MG = (u16*)(p.ws + WS_MERGED);
  const bool xcd_map = (gridDim.x == 256);
  for (int t = blockIdx.x, it = 0; t < 192 * 4; t += gridDim.x, ++it) {
    int nt = t & 3, mt = t >> 2;
    if (xcd_map) {
      const int x = blockIdx.x & 7, j = blockIdx.x >> 3;
      mt = x * 24 + it * 8 + (j & 7);
      nt = j >> 3;
    }
    const int tokm = mt * 256;
    f32x4 acc[2][2][4][2];
    zero_acc8(acc);
    gemm8(acc, WC + (size_t)nt * 256 * 512, 512, Y + (size_t)tokm * 512, 512, 512, lds);
    __syncthreads();
    stage_acc8(acc, lds, 528);
    __syncthreads();
    {
      const int tid = opaque_tid();
#pragma unroll 4
      for (int i = 0; i < 16; ++i) {
        const int id = tid + NT * i;
        const int row = id >> 5, ch = id & 31;
        unsigned char* ip = lds + row * 528 + ch * 16;
        const uint4 a = *(const uint4*)ip;
        const size_t go = (size_t)(tokm + row) * 2048 + nt * 256 + ch * 8;
        const uint4 ga = *(const uint4*)(GAB + go);
        const uint4 gb = *(const uint4*)(GAB + go + 1024);
#define P3A_R(gaw, gbw, lohi) ((1.f + __builtin_amdgcn_exp2f(-1.4426950408889634f * lohi(gbw))) * __builtin_amdgcn_rcpf(1.f + __builtin_amdgcn_exp2f(-1.4426950408889634f * lohi(gaw))))
        uint4 o;
        o.x = pack2(bflo(a.x) * P3A_R(ga.x, gb.x, bflo), bfhi(a.x) * P3A_R(ga.x, gb.x, bfhi));
        o.y = pack2(bflo(a.y) * P3A_R(ga.y, gb.y, bflo), bfhi(a.y) * P3A_R(ga.y, gb.y, bfhi));
        o.z = pack2(bflo(a.z) * P3A_R(ga.z, gb.z, bflo), bfhi(a.z) * P3A_R(ga.z, gb.z, bfhi));
        o.w = pack2(bflo(a.w) * P3A_R(ga.w, gb.w, bflo), bfhi(a.w) * P3A_R(ga.w, gb.w, bfhi));
#undef P3A_R
        *(uint4*)ip = o;
      }
    }
    __syncthreads();
    load_acc8(acc, lds, 528);
    __syncthreads();
    gemm8(acc, WA + (size_t)nt * 256 * 512, 512, O + (size_t)tokm * 512, 512, 512, lds);
    __syncthreads();
    stage_acc8(acc, lds, 528);
    __syncthreads();
    {
      const int tid = opaque_tid();
#pragma unroll 4
      for (int i = 0; i < 16; ++i) {
        const int id = tid + NT * i;
        const int row = id >> 5, ch = id & 31;
        const uint4 a = *(const uint4*)(lds + row * 528 + ch * 16);
        const size_t go = (size_t)(tokm + row) * 2048 + nt * 256 + ch * 8;
        const uint4 gb = *(const uint4*)(GAB + go + 1024);
        uint4 m;
        m.x = pack2(sigm_f(bflo(gb.x)) * bflo(a.x), sigm_f(bfhi(gb.x)) * bfhi(a.x));
        m.y = pack2(sigm_f(bflo(gb.y)) * bflo(a.y), sigm_f(bfhi(gb.y)) * bfhi(a.y));
        m.z = pack2(sigm_f(bflo(gb.z)) * bflo(a.z), sigm_f(bfhi(gb.z)) * bfhi(a.z));
        m.w = pack2(sigm_f(bflo(gb.w)) * bflo(a.w), sigm_f(bfhi(gb.w)) * bfhi(a.w));
        *(uint4*)(MG + (size_t)(tokm + row) * 1024 + nt * 256 + ch * 8) = m;
      }
    }
    asm volatile("s_waitcnt lgkmcnt(0)" ::: "memory");
    __builtin_amdgcn_s_barrier();
  }
}

DI void phase3b(const Params& p, unsigned char* lds) {
  const u16* MG = (const u16*)(p.ws + WS_MERGED);
  const u16* WO = (const u16*)(p.ws + WS_WO);
  const float* modb = (const float*)(p.ws + WS_MOD);
  for (int t = blockIdx.x; t < 192 * 4; t += gridDim.x) {
    const int nt = t & 3, mt = t >> 2;
    const int tokm = mt * 256;
    f32x4 acc[2][2][4][2];
    zero_acc8(acc);
    gemm8(acc, WO + (size_t)nt * 256 * 1024, 1024, MG + (size_t)tokm * 1024, 1024, 1024, lds);
    __syncthreads();
    stage_acc8(acc, lds, 528);
    __syncthreads();
    const int tid = opaque_tid();
    const int seq = (tokm < TP) ? (tokm >> 11) : 8 + ((tokm - TP) >> 14);
    const float* gate = modb + seq * 3072 + 2048 + nt * 256;
#pragma unroll
    for (int i = 0; i < 16; ++i) {
      const int id = tid + NT * i;
      const int row = id >> 5, ch = id & 31;
      const uint4 a = *(const uint4*)(lds + row * 528 + ch * 16);
      const int tk = tokm + row;
      const float* xr = ((tk < TP) ? p.x_p + (size_t)tk * 1024 : p.x_s + (size_t)(tk - TP) * 1024) + nt * 256 + ch * 8;
      float* orow = p.out + (size_t)tk * 1024 + nt * 256 + ch * 8;
      const float4 x0 = *(const float4*)(xr), x1 = *(const float4*)(xr + 4);
      const float4 g0 = *(const float4*)(gate + ch * 8), g1 = *(const float4*)(gate + ch * 8 + 4);
      float4 o0, o1;
      o0.x = x0.x + g0.x * bflo(a.x); o0.y = x0.y + g0.y * bfhi(a.x); o0.z = x0.z + g0.z * bflo(a.y); o0.w = x0.w + g0.w * bfhi(a.y);
      o1.x = x1.x + g1.x * bflo(a.z); o1.y = x1.y + g1.y * bfhi(a.z); o1.z = x1.z + g1.z * bflo(a.w); o1.w = x1.w + g1.w * bfhi(a.w);
      *(float4*)(orow) = o0;
      *(float4*)(orow + 4) = o1;
    }
    asm volatile("s_waitcnt lgkmcnt(0)" ::: "memory");
    __builtin_amdgcn_s_barrier();
  }
}


#define XB_TMO      128
#define XB_XCNT(j)  (256  + 64 * (j))
#define XB_XSUB(j)  (1280 + 64 * (j))
#define XB_XGEN(j)  (2304 + 64 * (j))
#define XB_TOP      3328
#define XB_TOPGEN   3392
#define XCD_BAR_WORDS 3456
#define XB_SPIN_CAP (1u << 18)
#define LAS __attribute__((address_space(3)))
DI unsigned xb_ld(unsigned* p) { return __hip_atomic_load(p, __ATOMIC_RELAXED, __HIP_MEMORY_SCOPE_AGENT); }
DI unsigned xb_add(unsigned* p, unsigned v) { return __hip_atomic_fetch_add(p, v, __ATOMIC_RELAXED, __HIP_MEMORY_SCOPE_AGENT); }
DI unsigned xb_xcc_id() { return (unsigned)__builtin_amdgcn_s_getreg((3 << 11) | 20) & 0xFu; }
#define XB_SPIN(cond, bar) do { unsigned _sp = 0; while (cond) { __builtin_amdgcn_s_sleep(1); \
    if ((++_sp & 255u) == 0u) { if (xb_ld(&(bar)[XB_TMO])) break; if (_sp > XB_SPIN_CAP) { atomicAdd(&(bar)[XB_TMO], 1u); break; } } } } while (0)
struct XcdBarrier { unsigned* bar; unsigned x; volatile LAS unsigned* st; };
DI XcdBarrier xcd_barrier_post(unsigned* bar, volatile LAS unsigned* st) {
  XcdBarrier b; b.bar = bar; b.x = xb_xcc_id(); b.st = st;
  if (threadIdx.x == 0) (void)xb_add(&bar[XB_XCNT(b.x)], 1u);
  return b;
}
DI void xcd_barrier_complete(unsigned* bar, unsigned x, unsigned& nloc, unsigned& nx) {
  const unsigned G = gridDim.x * gridDim.y * gridDim.z;
  unsigned sum, cnt, mine, sp = 0u;
  for (;;) {
    sum = 0u; cnt = 0u; mine = 0u;
#pragma unroll
    for (unsigned j = 0; j < 16; ++j) { const unsigned c = xb_ld(&bar[XB_XCNT(j)]); sum += c; cnt += (c > 0u) ? 1u : 0u; mine = (j == x) ? c : mine; }
    if (sum == G) break;
    __builtin_amdgcn_s_sleep(1);
    if ((++sp & 255u) == 0u) { if (xb_ld(&bar[XB_TMO])) break; if (sp > XB_SPIN_CAP) { atomicAdd(&bar[XB_TMO], 1u); break; } }
  }
  nloc = mine > 0u ? mine : 1u; nx = cnt > 0u ? cnt : 1u;
}
DI void xcd_barrier(const XcdBarrier& b) {
  asm volatile("s_waitcnt vmcnt(0)" ::: "memory");
  __syncthreads();
  if (threadIdx.x == 0) {
    unsigned* bar = b.bar;
    __builtin_amdgcn_s_waitcnt(0);
    unsigned nloc = b.st[0], nx = b.st[1];
    if (nloc == 0u) { xcd_barrier_complete(bar, b.x, nloc, nx); b.st[0] = nloc; b.st[1] = nx; }
    const unsigned old = xb_add(&bar[XB_XSUB(b.x)], 1u);
    const unsigned gen = old / nloc;
    if (old + 1u == (gen + 1u) * nloc) {
      __builtin_amdgcn_fence(__ATOMIC_RELEASE, "agent");
      asm volatile("s_waitcnt vmcnt(0)" ::: "memory");
      const unsigned og = xb_add(&bar[XB_TOP], 1u);
      const unsigned tg = og / nx;
      if (og + 1u == (tg + 1u) * nx) xb_add(&bar[XB_TOPGEN], 1u);
      else XB_SPIN(xb_ld(&bar[XB_TOPGEN]) == tg, bar);
      __builtin_amdgcn_fence(__ATOMIC_ACQUIRE, "agent");
      xb_add(&bar[XB_XGEN(b.x)], 1u);
      asm volatile("s_waitcnt vmcnt(0)" ::: "memory");
    } else {
      XB_SPIN(xb_ld(&bar[XB_XGEN(b.x)]) == gen, bar);
      __builtin_amdgcn_fence(__ATOMIC_ACQUIRE, "agent");
      asm volatile("s_waitcnt vmcnt(0)" ::: "memory");
    }
  }
  __syncthreads();
}

__global__ void __launch_bounds__(512) fwd_kernel(Params p) {
  extern __shared__ __attribute__((aligned(16))) unsigned char lds[];
  cg::grid_group grid = cg::this_grid();
  const int lo = p.ph_lo, hi = p.ph_hi;
  unsigned* barw = (unsigned*)(p.ws + WS_BAR);
  volatile LAS unsigned* st = (volatile LAS unsigned*)(lds + 139264);
  XcdBarrier xb; xb.bar = barw; xb.x = 0; xb.st = st;
  if ((PHM & 1) && lo <= 0 && 0 < hi) {
    if (1 < hi && blockIdx.x == 0) for (int i = threadIdx.x; i < XCD_BAR_WORDS; i += NT) barw[i] = 0u;
    for (int rep = 0; rep < 1 + ((REPM >> 0) & 1); ++rep) phase0a(p, lds);
    if (1 < hi) {
      grid.sync();
      if (threadIdx.x < 4) st[threadIdx.x] = 0u;
      __syncthreads();
      xb = xcd_barrier_post(barw, st);
    }
  }
  if ((PHM & 2) && lo <= 1 && 1 < hi) { for (int rep = 0; rep < 1 + ((REPM >> 1) & 1); ++rep) phase0b(p, lds); if (2 < hi) xcd_barrier(xb); }
  if ((PHM & 4) && lo <= 2 && 2 < hi) { for (int rep = 0; rep < 1 + ((REPM >> 2) & 1); ++rep) phase1(p, lds); if (3 < hi) xcd_barrier(xb); }
  if ((PHM & 8) && lo <= 3 && 3 < hi) { phase2(p, lds); if (4 < hi) xcd_barrier(xb); }
  if ((PHM & 16) && lo <= 4 && 4 < hi) { for (int rep = 0; rep < 1 + ((REPM >> 4) & 1); ++rep) phase3a(p, lds); if (5 < hi) xcd_barrier(xb); }
  if ((PHM & 32) && lo <= 5 && 5 < hi) { for (int rep = 0; rep < 1 + ((REPM >> 5) & 1); ++rep) phase3b(p, lds); }
}

extern "C" void kernel_launch(void* const* d_in, const int* in_sizes, int n_in, void* d_out, int out_size, void* d_ws, size_t ws_size,
                              hipStream_t stream) {
  static int grid = 0;
  if (grid == 0) {
    int dev = 0, cus = 0, per_cu = 0;
    hipGetDevice(&dev);
    hipDeviceGetAttribute(&cus, hipDeviceAttributeMultiprocessorCount, dev);
    hipFuncSetAttribute((const void*)fwd_kernel, hipFuncAttributeMaxDynamicSharedMemorySize, LDS_BYTES);
    hipOccupancyMaxActiveBlocksPerMultiprocessor(&per_cu, (const void*)fwd_kernel, NT, LDS_BYTES);
    if (per_cu < 1) { fprintf(stderr, "occupancy query returned %d\n", per_cu); per_cu = 1; }
    if (per_cu > 1) per_cu = 1;
    grid = cus * per_cu;
    if (ws_size < WS_END) fprintf(stderr, "workspace too small: %zu < %zu\n", ws_size, (size_t)WS_END);
  }
  Params p{};
  const float** f = (const float**)&p;
  for (int i = 0; i < 19; ++i) f[i] = (const float*)d_in[i];
  p.out = (float*)d_out;
  p.ws = (unsigned char*)d_ws;
  for (int i = 0; i < 8; ++i) p.invf[i] = pow(500000.0, -(double)i / 8.0) / (2.0 * M_PI);
#if ONE_LAUNCH
  p.ph_lo = 0; p.ph_hi = 6;
  void* args[] = {&p};
  hipError_t e = hipLaunchCooperativeKernel((const void*)fwd_kernel, dim3(grid), dim3(NT), args, LDS_BYTES, stream);
  if (e != hipSuccess) fprintf(stderr, "cooperative launch failed: %s (grid %d)\n", hipGetErrorString(e), grid);
#else
  for (int ph = 0; ph < 6; ++ph) {
    p.ph_lo = ph; p.ph_hi = ph + 1;
    hipLaunchKernelGGL(fwd_kernel, dim3(grid), dim3(NT), LDS_BYTES, stream, p);
  }
#endif
}
```
